# Optimizing an MI355X kernel written in HIP

```python
import jax, jax.numpy as jnp
from jax import lax
import numpy as np

D_MODEL = 1024
BATCH = 2
SEQ = 8192
DEPTH = 4

HEAD_DIM = 64
A_HEADS = 8
B_HEADS = 8
M_HEADS = 4
M_HEAD_DIM = 128
BRANCH_WIDTH = 512
N_BRANCH = 3
MOBA_BLOCK = 256
MOBA_TOPK = 3
IDX_HEADS = 8
IDX_DIM = 64
IDX_TOPK_MAX = 256
N_MEM = 256
ROPE_THETA = 500000.0
ROT_FRACTION = 4
Q_BLOCK = 128
RMS_EPS = 1e-6
IN_WIDTHS = (
    BRANCH_WIDTH, BRANCH_WIDTH, BRANCH_WIDTH, BRANCH_WIDTH,
    BRANCH_WIDTH, BRANCH_WIDTH, BRANCH_WIDTH, BRANCH_WIDTH,
    IDX_HEADS * IDX_DIM, IDX_DIM, IDX_HEADS,
    BRANCH_WIDTH, BRANCH_WIDTH,
    N_BRANCH * D_MODEL,
)
IN_COLS = sum(IN_WIDTHS)

kernel_name = 'gated_parallel_moba_dsa_memory_trunk'


def rmsnorm(x, g):
    xf = x.astype(jnp.float32)
    y = xf * lax.rsqrt(jnp.mean(xf * xf, axis=-1, keepdims=True) + RMS_EPS)
    return (y * g.astype(jnp.float32)).astype(x.dtype)


def partial_rope(x, pos):
    d = x.shape[-1]
    rot = d // ROT_FRACTION
    half = rot // 2
    inv_freq = ROPE_THETA ** (-jnp.arange(half, dtype=jnp.float32) / half)
    ang = pos.astype(jnp.float32)[:, None] * inv_freq[None, :]
    cos = jnp.cos(ang)[:, None, :].astype(x.dtype)
    sin = jnp.sin(ang)[:, None, :].astype(x.dtype)
    x1 = x[..., :half]
    x2 = x[..., half:rot]
    return jnp.concatenate([x1 * cos - x2 * sin, x2 * cos + x1 * sin, x[..., rot:]], axis=-1)


def masked_softmax(s, mask):
    s = jnp.where(mask, s.astype(jnp.float32), -jnp.inf)
    return jax.nn.softmax(s, axis=-1)


def moba_attention(q, k, v):
    b, s, h, d = q.shape
    nb = -(-s // MOBA_BLOCK)
    pad = nb * MOBA_BLOCK - s
    padw = ((0, 0), (0, pad), (0, 0), (0, 0))
    kb = jnp.pad(k, padw).reshape(b, nb, MOBA_BLOCK, h, d).transpose(0, 3, 1, 2, 4)
    vb = jnp.pad(v, padw).reshape(b, nb, MOBA_BLOCK, h, d).transpose(0, 3, 1, 2, 4)
    kmean = jnp.mean(kb.astype(jnp.float32), axis=3).astype(q.dtype)
    kk = min(MOBA_TOPK, nb - 1)
    scale = d ** -0.5
    b_idx = jnp.arange(b)[:, None, None, None]
    h_idx = jnp.arange(h)[None, :, None, None]
    blk_ids = jnp.arange(nb)

    def one_block(qi):
        start = qi * Q_BLOCK
        own = start // MOBA_BLOCK
        qpos = start + jnp.arange(Q_BLOCK)
        qb = lax.dynamic_slice_in_dim(q, start, Q_BLOCK, axis=1).transpose(0, 2, 1, 3)
        k_own = lax.dynamic_index_in_dim(kb, own, axis=2, keepdims=False)
        v_own = lax.dynamic_index_in_dim(vb, own, axis=2, keepdims=False)
        kpos_own = own * MOBA_BLOCK + jnp.arange(MOBA_BLOCK)
        s_own = jnp.einsum('bhqd,bhkd->bhqk', qb, k_own) * scale
        m_own = jnp.broadcast_to(kpos_own[None, :] <= qpos[:, None], s_own.shape)
        if kk == 0:
            p = masked_softmax(s_own, m_own).astype(v.dtype)
            o = jnp.einsum('bhqk,bhkd->bhqd', p, v_own)
        else:
            gate = jnp.einsum('bhqd,bhnd->bhqn', qb, kmean).astype(jnp.float32)
            gate = jnp.where(blk_ids < own, gate, -jnp.inf)
            _, sel = lax.top_k(gate, kk)
            valid = sel < own
            kg = kb[b_idx, h_idx, sel]
            vg = vb[b_idx, h_idx, sel]
            s_past = jnp.einsum('bhqd,bhqjkd->bhqjk', qb, kg) * scale
            m_past = jnp.broadcast_to(valid[..., None], s_past.shape)
            n_past = kk * MOBA_BLOCK
            s_all = jnp.concatenate([s_past.reshape(b, h, Q_BLOCK, n_past), s_own], axis=-1)
            m_all = jnp.concatenate([m_past.reshape(b, h, Q_BLOCK, n_past), m_own], axis=-1)
            p = masked_softmax(s_all, m_all).astype(v.dtype)
            p_past = p[..., :n_past].reshape(b, h, Q_BLOCK, kk, MOBA_BLOCK)
            o = (jnp.einsum('bhqjk,bhqjkd->bhqd', p_past, vg)
                 + jnp.einsum('bhqk,bhkd->bhqd', p[..., n_past:], v_own))
        return o.transpose(0, 2, 1, 3)

    out = lax.map(one_block, jnp.arange(s // Q_BLOCK))
    return out.transpose(1, 0, 2, 3, 4).reshape(b, s, h, d)


def dsa_attention(q, k, v, qi, ki, wi):
    b, s, h, d = q.shape
    n_sel = min(IDX_TOPK_MAX, s // 4)
    scale = d ** -0.5
    kpos = jnp.arange(s)
    b_idx = jnp.arange(b)[:, None, None]

    def one_block(blk):
        start = blk * Q_BLOCK
        qpos = start + jnp.arange(Q_BLOCK)
        q_b = lax.dynamic_slice_in_dim(q, start, Q_BLOCK, axis=1)
        qi_b = lax.dynamic_slice_in_dim(qi, start, Q_BLOCK, axis=1)
        wi_b = lax.dynamic_slice_in_dim(wi, start, Q_BLOCK, axis=1)
        rel = jax.nn.relu(jnp.einsum('bqhd,bsd->bqhs', qi_b, ki))
        idx_score = jnp.einsum('bqhs,bqh->bqs', rel, wi_b).astype(jnp.float32)
        idx_score = jnp.where(kpos[None, :] <= qpos[:, None], idx_score, -jnp.inf)
        _, sel = lax.top_k(idx_score, n_sel)
        valid = sel <= qpos[None, :, None]
        kg = k[b_idx, sel]
        vg = v[b_idx, sel]
        sc = jnp.einsum('bqhd,bqnhd->bqhn', q_b, kg) * scale
        p = masked_softmax(sc, valid[:, :, None, :]).astype(v.dtype)
        return jnp.einsum('bqhn,bqnhd->bqhd', p, vg)

    out = lax.map(one_block, jnp.arange(s // Q_BLOCK))
    return out.transpose(1, 0, 2, 3, 4).reshape(b, s, h, d)


def memory_attention(qm, km, vm):
    sc = jnp.einsum('bshd,bmhd->bhsm', qm, km) * (qm.shape[-1] ** -0.5)
    p = jax.nn.softmax(sc.astype(jnp.float32), axis=-1).astype(vm.dtype)
    return jnp.einsum('bhsm,bmhd->bshd', p, vm)


def hybrid_layer(x, mem, pos, norm_g, w_in, mem_norm_g, w_mem_kv, w_branch, w_out):
    b, s, _ = x.shape
    h = rmsnorm(x, norm_g)
    proj = jnp.einsum('bsd,dc->bsc', h, w_in)
    offs = np.cumsum(IN_WIDTHS)[:-1].tolist()
    (a_q, a_k, a_v, a_g, b_q, b_k, b_v, b_g,
     i_q, i_k, i_w, m_q, m_g, mix) = jnp.split(proj, offs, axis=-1)

    qa = partial_rope(a_q.reshape(b, s, A_HEADS, HEAD_DIM), pos)
    ka = partial_rope(a_k.reshape(b, s, A_HEADS, HEAD_DIM), pos)
    va = a_v.reshape(b, s, A_HEADS, HEAD_DIM)
    ya = moba_attention(qa, ka, va).reshape(b, s, BRANCH_WIDTH) * jax.nn.silu(a_g)

    qb = partial_rope(b_q.reshape(b, s, B_HEADS, HEAD_DIM), pos)
    kb = partial_rope(b_k.reshape(b, s, B_HEADS, HEAD_DIM), pos)
    vb = b_v.reshape(b, s, B_HEADS, HEAD_DIM)
    qi = partial_rope(i_q.reshape(b, s, IDX_HEADS, IDX_DIM), pos) * (IDX_DIM ** -0.5)
    ki = partial_rope(i_k[:, :, None, :], pos)[:, :, 0, :]
    wi = i_w * (IDX_HEADS ** -0.5)
    yb = dsa_attention(qb, kb, vb, qi, ki, wi).reshape(b, s, BRANCH_WIDTH) * jax.nn.silu(b_g)

    mn = rmsnorm(mem, mem_norm_g)
    km, vm = jnp.split(jnp.einsum('bmd,dc->bmc', mn, w_mem_kv), 2, axis=-1)
    km = km.reshape(b, -1, M_HEADS, M_HEAD_DIM)
    vm = vm.reshape(b, -1, M_HEADS, M_HEAD_DIM)
    ym = memory_attention(m_q.reshape(b, s, M_HEADS, M_HEAD_DIM), km, vm)
    ym = ym.reshape(b, s, BRANCH_WIDTH) * jax.nn.silu(m_g)

    ys = jnp.stack([ya, yb, ym], axis=2)
    up = jnp.einsum('bsnw,nwd->bsnd', ys, w_branch)
    gates = jax.nn.sigmoid(mix.reshape(b, s, N_BRANCH, D_MODEL))
    merged = jnp.sum(gates * up, axis=2)
    return x + jnp.einsum('bsd,de->bse', merged, w_out)


def setup_inputs(seed: int = 0) -> dict:
    key = jax.random.key(seed)
    ks = jax.random.split(key, 9)
    f32 = jnp.float32
    x = jax.random.normal(ks[0], (BATCH, SEQ, D_MODEL), f32)
    mem = jax.random.normal(ks[1], (BATCH, N_MEM, D_MODEL), f32)
    norm_g = 1.0 + 0.02 * jax.random.normal(ks[2], (DEPTH, D_MODEL), f32)
    w_in = jax.random.normal(ks[3], (DEPTH, D_MODEL, IN_COLS), f32) * (D_MODEL ** -0.5)
    mem_norm_g = 1.0 + 0.02 * jax.random.normal(ks[4], (DEPTH, D_MODEL), f32)
    w_mem_kv = jax.random.normal(ks[5], (DEPTH, D_MODEL, 2 * BRANCH_WIDTH), f32) * (D_MODEL ** -0.5)
    w_branch = jax.random.normal(ks[6], (DEPTH, N_BRANCH, BRANCH_WIDTH, D_MODEL), f32) * (BRANCH_WIDTH ** -0.5)
    w_out = jax.random.normal(ks[7], (DEPTH, D_MODEL, D_MODEL), f32) * (D_MODEL ** -0.5)
    final_g = 1.0 + 0.02 * jax.random.normal(ks[8], (D_MODEL,), f32)
    return {'x': x, 'mem': mem, 'norm_g': norm_g, 'w_in': w_in, 'mem_norm_g': mem_norm_g,
            'w_mem_kv': w_mem_kv, 'w_branch': w_branch, 'w_out': w_out, 'final_g': final_g}


def reference(x, mem, norm_g, w_in, mem_norm_g, w_mem_kv, w_branch, w_out, final_g):
    pos = jnp.arange(x.shape[1], dtype=jnp.int32)
    for l in range(DEPTH):
        x = hybrid_layer(x, mem, pos, norm_g[l], w_in[l], mem_norm_g[l], w_mem_kv[l],
                         w_branch[l], w_out[l])
    return rmsnorm(x, final_g)
```

```cpp
#include <hip/hip_runtime.h>
#include <hip/hip_cooperative_groups.h>
#include <cstdio>
#include <cstdint>
namespace cg = cooperative_groups;

#define LAS __attribute__((address_space(3)))
typedef _Float16 f16;
typedef _Float16 f16x8 __attribute__((ext_vector_type(8)));
typedef _Float16 f16x4 __attribute__((ext_vector_type(4)));
typedef _Float16 f16x2 __attribute__((ext_vector_type(2)));
typedef float f32x4 __attribute__((ext_vector_type(4)));
typedef float f32x2 __attribute__((ext_vector_type(2)));
typedef unsigned u32x4 __attribute__((ext_vector_type(4)));
typedef unsigned u32x2 __attribute__((ext_vector_type(2)));
typedef unsigned long long u64;

constexpr int DM = 1024, BATCH = 2, SEQ = 8192, M = BATCH * SEQ, DEPTH = 4;
constexpr int INC = 8776;
constexpr int NPHYS = 5888;
constexpr int NMEM = 256;
constexpr float RMS_EPS = 1e-6f;
constexpr float LOG2E = 1.4426950408889634f;
constexpr float C2_64 = 0.125f * LOG2E;
constexpr float C2_128 = 0.08838834764831845f * LOG2E;
constexpr int L_AQ = 0, L_AK = 512, L_AV = 1024, L_AG = 1536, L_BQ = 2048, L_BK = 2560, L_BV = 3072, L_BG = 3584, L_IQ = 4096, L_IK = 4608, L_IW = 4672, L_MQ = 4680, L_MG = 5192, L_MIX = 5704;

constexpr size_t MiB = 1u << 20;
constexpr size_t WS_CTL = 0;
constexpr size_t WS_WIN = 1 * MiB;
constexpr size_t WS_WMIX = WS_WIN + 46 * MiB;
constexpr size_t WS_WMKV = WS_WMIX + 24 * MiB;
constexpr size_t WS_WBR = WS_WMKV + 8 * MiB;
constexpr size_t WS_WOUT = WS_WBR + 12 * MiB;
constexpr size_t WS_XH = WS_WOUT + 24 * MiB;
constexpr size_t WS_MEMN = WS_XH + 32 * MiB;
constexpr size_t WS_KVM = WS_MEMN + 1 * MiB;
constexpr size_t WS_ROPE = WS_KVM + 4 * MiB;
constexpr size_t WS_KMEAN = WS_ROPE + (MiB / 2);
constexpr size_t WS_SEL = WS_KMEAN + (MiB / 2);
constexpr size_t WS_SS = WS_SEL + (MiB / 2);
constexpr size_t WS_WI = WS_SS + 1 * MiB;
constexpr size_t WS_KI = WS_WI + 1 * MiB;
constexpr size_t WS_BITS = WS_KI + 2 * MiB;
constexpr size_t WS_Y = WS_BITS + 16 * MiB;
constexpr size_t WS_P1 = WS_Y + 48 * MiB;
constexpr size_t WS_QA = WS_P1, WS_KA = WS_QA + 16 * MiB, WS_VA = WS_KA + 16 * MiB, WS_QB = WS_VA + 16 * MiB, WS_KB = WS_QB + 16 * MiB, WS_VB = WS_KB + 16 * MiB,
                 WS_QI = WS_VB + 16 * MiB, WS_QM = WS_QI + 16 * MiB, WS_G = WS_QM + 16 * MiB;
constexpr size_t WS_MG = WS_QI;
constexpr size_t WS_GU = WS_P1;
constexpr size_t WS_SC = WS_G + 48 * MiB;
constexpr size_t WS_END = WS_SC + 131 * MiB;
constexpr int NCHUNK = 1;
__device__ __forceinline__ int ch_t(int c) { return c == 0 ? 0 : 8192; }
constexpr size_t SC_PB = (size_t)4096 * 64 * 65;
__device__ __forceinline__ size_t sc_row(int t) { const int k0 = t >> 7; return (size_t)4096 * k0 * (k0 + 1) + (size_t)64 * (t & 127) * (k0 + 1); }

__device__ __forceinline__ unsigned pk_f16(float lo, float hi) { f32x2 v = {lo, hi}; f16x2 h = __builtin_convertvector(v, f16x2); return __builtin_bit_cast(unsigned, h); }
template <int O> __device__ __forceinline__ float xor_lane(float v) {
    static_assert(O < 32, "xor_lane: inside a 32-lane half only");
    return __uint_as_float((unsigned)__builtin_amdgcn_ds_swizzle((int)__float_as_uint(v), (O << 10) | 0x1F));
}
__device__ __forceinline__ float wave_sum(float v) {
    v += xor_lane<1>(v); v += xor_lane<2>(v); v += xor_lane<4>(v); v += xor_lane<8>(v); v += xor_lane<16>(v);
    { auto rr = __builtin_amdgcn_permlane32_swap(__float_as_uint(v), __float_as_uint(v), false, false); v = __uint_as_float(rr[0]) + __uint_as_float(rr[1]); }
    return v;
}
__device__ __forceinline__ float wave_max(float v) {
    v = fmaxf(v, xor_lane<1>(v)); v = fmaxf(v, xor_lane<2>(v)); v = fmaxf(v, xor_lane<4>(v)); v = fmaxf(v, xor_lane<8>(v)); v = fmaxf(v, xor_lane<16>(v));
    { auto rr = __builtin_amdgcn_permlane32_swap(__float_as_uint(v), __float_as_uint(v), false, false); v = fmaxf(__uint_as_float(rr[0]), __uint_as_float(rr[1])); }
    return v;
}
__device__ __forceinline__ float silu_f(float x) { return x * __builtin_amdgcn_rcpf(1.0f + __builtin_amdgcn_exp2f(-x * LOG2E)); }
__device__ __forceinline__ float sigmoid_f(float x) { return __builtin_amdgcn_rcpf(1.0f + __builtin_amdgcn_exp2f(-x * LOG2E)); }
__host__ __device__ __forceinline__ int unperm64(int p) { return p < 16 ? ((p & 1) ? (p >> 1) + 8 : (p >> 1)) : p; }

constexpr int WTAB_OFF = 131072 + 4096 + 64;
__device__ __forceinline__ int opaque_tid() {
    extern __shared__ __attribute__((aligned(16))) unsigned char lds_dyn_[];
    unsigned hw = (unsigned)__builtin_amdgcn_s_getreg((5 << 11) | 4) & 63u; asm volatile("" : "+s"(hw));
    const unsigned wid = ((volatile LAS unsigned*)((LAS unsigned char*)lds_dyn_ + WTAB_OFF))[hw];
    unsigned lane; asm volatile("v_mbcnt_lo_u32_b32 %0, -1, 0\n\tv_mbcnt_hi_u32_b32 %0, -1, %0" : "=v"(lane));
    return (int)(((unsigned)__builtin_amdgcn_readfirstlane((int)wid) << 6) | lane);
}
typedef float f32x16_t __attribute__((ext_vector_type(16)));
__device__ __forceinline__ f32x16_t zero16_here() { float z; asm volatile("v_mov_b32 %0, 0" : "=v"(z)); f32x16_t r;
#pragma unroll
    for (int i = 0; i < 16; ++i) r[i] = z;
    return r; }
__device__ __forceinline__ unsigned char* opaque_ptr(unsigned char* p) { unsigned long long v = (unsigned long long)p; asm volatile("" : "+s"(v)); return (unsigned char*)(__attribute__((address_space(1))) unsigned char*)v; }
__device__ __forceinline__ int o_grid() { int g = gridDim.x; asm volatile("" : "+s"(g)); return g; }
__device__ __forceinline__ int o_blk() { int b = blockIdx.x; asm volatile("" : "+s"(b)); return b; }
struct Params {
    const float* x; const float* mem; const float* norm_g; const float* w_in; const float* mem_norm_g; const float* w_mem_kv; const float* w_branch; const float* w_out; const float* final_g;
    float* out; unsigned char* ws;
};

namespace pg8 {
constexpr int BM = 256, BK = 64, HALF = 128, HTB = HALF * BK * 2, STAGE_BYTES = 8 * HTB;
__host__ __device__ __forceinline__ int lds_byte(int r, int c) { const int st = (r >> 4) * 2 + (c >> 5), rr = r & 15, cc = c & 31, ob = rr * 64 + cc * 2; return st * 1024 + (ob ^ (((ob >> 9) & 1) << 5)); }
__host__ __device__ __forceinline__ void stage_rc(int b, int& R, int& C) { const int st = b / 1024, sb = b % 1024, swz = sb ^ (((sb >> 9) & 1) << 5); R = (st >> 1) * 16 + swz / 64; C = (st & 1) * 32 + (swz % 64) / 2; }
__host__ __device__ __forceinline__ int perm32(int rho) { const int n = rho >> 4, i = rho & 15; return 8 * (i >> 2) + 4 * n + (i & 3); }

enum Kind { K_INPROJ = 0, K_MEMKV = 1, K_UP = 2, K_MIX = 3, K_OUT = 4 };
struct Unit {
    const char* A; const char* B;
    int kind, pm, pn, aux;
};

template <unsigned LDA2, unsigned LDB2, int NT, class Sched, class Epi>
__device__ __forceinline__ void gemm_phase(LAS unsigned char* lds, const Sched& S, const Epi& E) {
    const int tid = opaque_tid(), wid = __builtin_amdgcn_readfirstlane(tid >> 6), lane = tid & 63, wr = wid >> 2, wc = wid & 3, fr = lane & 15, fq = lane >> 4;
    unsigned RA[2], RB[2], CC[2];
#pragma unroll
    for (int i = 0; i < 2; ++i) { int R, C; stage_rc(tid * 16 + i * 8192, R, C); RA[i] = (unsigned)R; RB[i] = (unsigned)((R & ~31) + perm32(R & 31)); CC[i] = (unsigned)(C * 2); }
    const size_t kstep = (size_t)(BK * 2);
    const unsigned ldsw = (unsigned)wid * 1024u;
    const int aoff = lds_byte(wr * 64 + fr, fq * 8), boff = lds_byte(wc * 32 + fr, fq * 8);
#define PG8_SA(b, h) (((b) * 2 + (h)) * HTB)
#define PG8_SB(b, h) ((4 + (b) * 2 + (h)) * HTB)
#define PG8_STAGE(bufoff, gbase, v0, v1) do { \
        __builtin_amdgcn_global_load_lds((const unsigned*)((const char*)(gbase) + (v0)), (LAS unsigned*)(lds + (bufoff) + ldsw), 16, 0, 0); \
        __builtin_amdgcn_global_load_lds((const unsigned*)((const char*)(gbase) + (v1)), (LAS unsigned*)(lds + (bufoff) + ldsw + 8192), 16, 0, 0); } while (0)
#define PG8_LDA(dst, b, h) do { _Pragma("unroll") for (int m = 0; m < 4; ++m) _Pragma("unroll") for (int k = 0; k < 2; ++k) dst[m][k] = *(const LAS f16x8*)(lds + PG8_SA(b, h) + aoff + m * 2048 + k * 1024); } while (0)
#define PG8_LDB(dst, b, h) do { _Pragma("unroll") for (int n = 0; n < 2; ++n) _Pragma("unroll") for (int k = 0; k < 2; ++k) dst[n][k] = *(const LAS f16x8*)(lds + PG8_SB(b, h) + boff + n * 2048 + k * 1024); } while (0)
#define PG8_MMA(ai, bj, At, Bt) do { __builtin_amdgcn_s_setprio(1); _Pragma("unroll") for (int m = 0; m < 4; ++m) _Pragma("unroll") for (int n = 0; n < 2; ++n) _Pragma("unroll") for (int k = 0; k < 2; ++k) \
        acc[ai][bj][m][n] = __builtin_amdgcn_mfma_f32_16x16x32_f16(Bt[n][k], At[m][k], acc[ai][bj][m][n], 0, 0, 0); __builtin_amdgcn_s_setprio(0); } while (0)
#define PG8_WAIT_V(n) asm volatile("s_waitcnt vmcnt(" #n ")" ::: "memory")
#define PG8_WAIT_L(n) asm volatile("s_waitcnt lgkmcnt(" #n ")" ::: "memory")
#define PG8_BAR __builtin_amdgcn_s_barrier()
#define PG8_SCHED __builtin_amdgcn_sched_barrier(0)
    Unit cur, nxt; int ui = 0;
    if (!S.next(0, cur)) return;
    float pre_cur = E.pre(cur, tid);
    f32x4 acc[2][2][4][2];
#pragma unroll
    for (int a = 0; a < 2; ++a)
#pragma unroll
        for (int b = 0; b < 2; ++b)
#pragma unroll
            for (int m = 0; m < 4; ++m)
#pragma unroll
                for (int n = 0; n < 2; ++n) acc[a][b][m][n] = (f32x4){0.f, 0.f, 0.f, 0.f};
    f16x8 At[4][2], B0[2][2], B1[2][2];
    const char* cA = cur.A; const char* cB = cur.B;
    const unsigned cvA0 = RA[0] * LDA2 + CC[0], cvA1 = RA[1] * LDA2 + CC[1], cvB0 = RB[0] * LDB2 + CC[0], cvB1 = RB[1] * LDB2 + CC[1];
    constexpr size_t chA = (size_t)HALF * LDA2, chB = (size_t)HALF * LDB2;
    PG8_STAGE(PG8_SB(0, 0), cB, cvB0, cvB1); PG8_STAGE(PG8_SB(0, 1), cB + chB, cvB0, cvB1); PG8_STAGE(PG8_SA(0, 0), cA, cvA0, cvA1); PG8_STAGE(PG8_SA(0, 1), cA + chA, cvA0, cvA1);
    if (wr == 1) PG8_BAR;
    PG8_WAIT_V(2); PG8_BAR;
    PG8_STAGE(PG8_SB(1, 0), cB + kstep, cvB0, cvB1); PG8_STAGE(PG8_SA(1, 0), cA + kstep, cvA0, cvA1); PG8_STAGE(PG8_SB(1, 1), cB + chB + kstep, cvB0, cvB1);
    PG8_WAIT_V(6); PG8_BAR;
    for (;;) {
        const bool has_next = S.next(ui + 1, nxt);
        if (!has_next) nxt = cur;
        const char* nA = nxt.A; const char* nB = nxt.B;
        constexpr int nt = NT;
        for (int t = 0; t < nt; t += 2) {
            const bool last = (t == nt - 2);
            const char* a1 = cA + (size_t)(t + 1) * kstep;
            const char* a2 = last ? nA : cA + (size_t)(t + 2) * kstep; const char* b2 = last ? nB : cB + (size_t)(t + 2) * kstep;
            const char* a3 = a2 + kstep; const char* b3 = b2 + kstep;
            const unsigned xA0 = cvA0, xA1 = cvA1, xB0 = cvB0, xB1 = cvB1;
            constexpr size_t xhA = chA, xhB = chB;
            PG8_LDB(B0, 0, 0); PG8_LDB(B1, 0, 1); PG8_SCHED; PG8_LDA(At, 0, 0); PG8_STAGE(PG8_SA(1, 1), a1 + chA, cvA0, cvA1);
            PG8_WAIT_V(8); PG8_WAIT_L(0); PG8_BAR; PG8_MMA(0, 0, At, B0); PG8_MMA(0, 1, At, B1); PG8_BAR; PG8_SCHED;
            PG8_LDA(At, 0, 1); PG8_STAGE(PG8_SB(0, 0), b2, xB0, xB1); PG8_STAGE(PG8_SB(0, 1), b2 + xhB, xB0, xB1); PG8_STAGE(PG8_SA(0, 0), a2, xA0, xA1);
            PG8_WAIT_V(8); PG8_WAIT_L(0); PG8_BAR; PG8_MMA(1, 0, At, B0); PG8_MMA(1, 1, At, B1); PG8_BAR; PG8_SCHED;
            PG8_LDB(B0, 1, 0); PG8_LDB(B1, 1, 1); PG8_SCHED; PG8_LDA(At, 1, 0); PG8_STAGE(PG8_SA(0, 1), a2 + xhA, xA0, xA1);
            PG8_WAIT_V(8); PG8_WAIT_L(0); PG8_BAR; PG8_MMA(0, 0, At, B0); PG8_MMA(0, 1, At, B1); PG8_BAR; PG8_SCHED;
            PG8_LDA(At, 1, 1); PG8_STAGE(PG8_SB(1, 0), b3, xB0, xB1); PG8_STAGE(PG8_SB(1, 1), b3 + xhB, xB0, xB1); PG8_STAGE(PG8_SA(1, 0), a3, xA0, xA1);
            PG8_WAIT_V(8); PG8_WAIT_L(0); PG8_BAR; PG8_MMA(1, 0, At, B0); PG8_MMA(1, 1, At, B1); PG8_BAR; PG8_SCHED;
        }
        if (wr == 0) PG8_BAR;
        const float pre_nxt = has_next ? E.pre(nxt, tid) : 0.f;
        E(acc, cur, wr, wc, fr, fq, tid, pre_cur);
        if (!has_next) break;
        pre_cur = pre_nxt;
#pragma unroll
        for (int a = 0; a < 2; ++a)
#pragma unroll
            for (int b = 0; b < 2; ++b)
#pragma unroll
                for (int m = 0; m < 4; ++m)
#pragma unroll
                    for (int n = 0; n < 2; ++n) acc[a][b][m][n] = (f32x4){0.f, 0.f, 0.f, 0.f};
        cur = nxt; cA = nA; cB = nB; ++ui;
        if (wr == 1) PG8_BAR;
    }
    PG8_WAIT_V(0);
    PG8_BAR;
#undef PG8_SA
#undef PG8_SB
#undef PG8_STAGE
#undef PG8_LDA
#undef PG8_LDB
#undef PG8_MMA
#undef PG8_WAIT_V
#undef PG8_WAIT_L
#undef PG8_BAR
#undef PG8_SCHED
}

__device__ __forceinline__ void tile_of(int wgid, int nM, int nN, int& pm, int& pn) {
    const int nwg = nM * nN;
    { const int q = nwg / 8, r = nwg % 8, xcd = wgid % 8, off = wgid / 8; wgid = (xcd < r ? xcd * (q + 1) : r * (q + 1) + (xcd - r) * q) + off; }
    const int nig = 8 * nN, gid = wgid / nig, fm = gid * 8, gsz = (nM - fm) < 8 ? (nM - fm) : 8;
    pm = fm + ((wgid % nig) % gsz); pn = (wgid % nig) / gsz;
}
}

template <int KSET>
struct Epi {
    unsigned char* ws; const float* xin; float* xout; int layer; LAS unsigned char* lds_misc;
    __device__ __forceinline__ float row_rstd(int row) const {
        const f32x4* p = (const f32x4*)(ws + WS_SS) + (size_t)row * 4;
        const f32x4 a = p[0], b = p[1], c = p[2], d = p[3];
        const float s = ((a[0] + a[1]) + (a[2] + a[3])) + ((b[0] + b[1]) + (b[2] + b[3])) + ((c[0] + c[1]) + (c[2] + c[3])) + ((d[0] + d[1]) + (d[2] + d[3]));
        return __builtin_amdgcn_rsqf(s * (1.0f / DM) + RMS_EPS);
    }
    template <int SUB>
    __device__ __forceinline__ void inproj_tile(const f32x4 (&acc)[2][2][4][2], f16* dst, int ld, int rbase, int cl0, int wr, int fr, LAS float* rtab, float* kmdst = nullptr) const {
        const f32x2* rope = (const f32x2*)(ws + WS_ROPE);
        f32x4 cs[2][2];
#pragma unroll
        for (int bj = 0; bj < 2; ++bj) { cs[bj][0] = (f32x4){0.f, 0.f, 0.f, 0.f}; cs[bj][1] = (f32x4){0.f, 0.f, 0.f, 0.f}; }
#pragma unroll
        for (int ai = 0; ai < 2; ++ai)
#pragma unroll
            for (int m = 0; m < 4; ++m) {
                const int row = rbase + ai * 128 + m * 16;
                const float rs = rtab[ai * 128 + wr * 64 + m * 16 + fr];
                const int pos = row & (SEQ - 1);
#pragma unroll
                for (int bj = 0; bj < 2; ++bj) {
                    f32x4 v0 = acc[ai][bj][m][0] * rs, v1 = acc[ai][bj][m][1] * rs;
                    const int cl = cl0 + bj * 128;
                    if (SUB == 7 && cl >= 64) {
                        if (cl == 64) { const float s8 = 0.35355339059327373f; f32x4* d = (f32x4*)((float*)(ws + WS_WI) + (size_t)row * 8); d[0] = v0 * s8; d[1] = v1 * s8; }
                        continue;
                    }
                    if (SUB == 0 || SUB == 1 || SUB == 4 || SUB == 7) {
                        if ((cl & 63) < 16) {
                            const f32x2* rp = rope + (size_t)pos * 8 + ((cl & 63) >> 1);
                            const f32x2 r0 = rp[0], r1 = rp[1], r2 = rp[2], r3 = rp[3];
                            f32x4 w0, w1;
                            w0[0] = v0[0] * r0[0] - v0[1] * r0[1]; w0[1] = v0[1] * r0[0] + v0[0] * r0[1];
                            w0[2] = v0[2] * r1[0] - v0[3] * r1[1]; w0[3] = v0[3] * r1[0] + v0[2] * r1[1];
                            w1[0] = v1[0] * r2[0] - v1[1] * r2[1]; w1[1] = v1[1] * r2[0] + v1[0] * r2[1];
                            w1[2] = v1[2] * r3[0] - v1[3] * r3[1]; w1[3] = v1[3] * r3[0] + v1[2] * r3[1];
                            v0 = w0; v1 = w1;
                        }
                    }
                    if (SUB == 1) { cs[bj][0] += v0; cs[bj][1] += v1; }
                    if (SUB == 0) { v0 = v0 * C2_64; v1 = v1 * C2_64; }
                    if (SUB == 4) { v0 = v0 * 0.125f; v1 = v1 * 0.125f; }
                    if (SUB == 5) { v0 = v0 * C2_128; v1 = v1 * C2_128; }
                    if (SUB == 3) {
#pragma unroll
                        for (int j = 0; j < 4; ++j) { v0[j] = silu_f(v0[j]); v1[j] = silu_f(v1[j]); }
                    }
                    u32x4 w; w.x = pk_f16(v0[0], v0[1]); w.y = pk_f16(v0[2], v0[3]); w.z = pk_f16(v1[0], v1[1]); w.w = pk_f16(v1[2], v1[3]);
                    *(u32x4*)(dst + (size_t)row * ld + cl) = w;
                }
            }
        if (SUB == 1) {
            if (kmdst) {
                LAS float* red = rtab + 256;
                const int wcq = (cl0 >> 3);
#pragma unroll
                for (int bj = 0; bj < 2; ++bj)
#pragma unroll
                    for (int n = 0; n < 2; ++n)
#pragma unroll
                        for (int j = 0; j < 4; ++j) { float v = cs[bj][n][j]; v += xor_lane<1>(v); v += xor_lane<2>(v); v += xor_lane<4>(v); v += xor_lane<8>(v);
                            if (fr == 0) red[wr * 256 + bj * 128 + wcq * 8 + n * 4 + j] = v; }
                asm volatile("s_waitcnt lgkmcnt(0)" ::: "memory"); __builtin_amdgcn_s_barrier(); asm volatile("" ::: "memory");
                if (wr == 0 && fr == 0) {
#pragma unroll
                    for (int bj = 0; bj < 2; ++bj)
#pragma unroll
                        for (int k = 0; k < 8; ++k) { const int i = bj * 128 + wcq * 8 + k; kmdst[i] = (red[i] + red[256 + i]) * (1.0f / 256.0f); }
                }
            }
        }
    }
    __device__ __forceinline__ float pre(const pg8::Unit& u, int tid) const {
        if ((KSET == 2 || (KSET == 0 && u.kind == pg8::K_INPROJ)) && tid < 256) return row_rstd(u.pm * 256 + tid);
        return 0.f;
    }
    __device__ __forceinline__ void operator()(const f32x4 (&acc)[2][2][4][2], const pg8::Unit& u, int wr, int wc, int fr, int fq, int tid, float pre) const {
        LAS float* rtab = (LAS float*)lds_misc;
        if (KSET == 2 || (KSET == 0 && u.kind == pg8::K_INPROJ)) {
            if (tid < 256) rtab[tid] = pre;
            asm volatile("s_waitcnt lgkmcnt(0)" ::: "memory"); __builtin_amdgcn_s_barrier(); asm volatile("" ::: "memory");
        } else if (KSET == 0) { __builtin_amdgcn_s_barrier(); }
        const int kind = (KSET == 0) ? u.kind : (KSET == 1) ? pg8::K_UP : (KSET == 2) ? pg8::K_MIX : pg8::K_OUT;
        const int rbase = u.pm * 256 + wr * 64 + fr;
        const int cl0 = wc * 32 + 8 * fq;
        if (KSET == 0 && kind == pg8::K_INPROJ) {
            const int pn = u.pn;
            if (pn < 16) { const int seg = pn >> 1, st = seg & 3;
                if (st == 0) inproj_tile<0>(acc, (f16*)(ws + (seg < 4 ? WS_QA : WS_QB)) + (pn & 1) * 256, 512, rbase, cl0, wr, fr, rtab);
                else if (st == 1) inproj_tile<1>(acc, (f16*)(ws + (seg < 4 ? WS_KA : WS_KB)) + (pn & 1) * 256, 512, rbase, cl0, wr, fr, rtab,
                                                 seg < 4 ? (float*)(ws + WS_KMEAN) + (size_t)u.pm * 512 + (pn & 1) * 256 : nullptr);
                else if (st == 2) inproj_tile<2>(acc, (f16*)(ws + (seg < 4 ? WS_VA : WS_VB)) + (pn & 1) * 256, 512, rbase, cl0, wr, fr, rtab);
                else inproj_tile<3>(acc, (f16*)(ws + WS_G) + (seg >> 2) * 512 + (pn & 1) * 256, 1536, rbase, cl0, wr, fr, rtab);
            } else if (pn < 18) inproj_tile<4>(acc, (f16*)(ws + WS_QI) + (pn & 1) * 256, 512, rbase, cl0, wr, fr, rtab);
            else if (pn < 20) inproj_tile<5>(acc, (f16*)(ws + WS_QM) + (pn & 1) * 256, 512, rbase, cl0, wr, fr, rtab);
            else if (pn < 22) inproj_tile<3>(acc, (f16*)(ws + WS_G) + 1024 + (pn & 1) * 256, 1536, rbase, cl0, wr, fr, rtab);
            else inproj_tile<7>(acc, (f16*)(ws + WS_KI), 64, rbase, cl0, wr, fr, rtab);
        } else if (KSET == 0) {
            f16* dstb = (f16*)(ws + WS_KVM) + (size_t)u.aux * 512 * 1024;
#pragma unroll
            for (int ai = 0; ai < 2; ++ai)
#pragma unroll
                for (int m = 0; m < 4; ++m) {
                    const int row = rbase + ai * 128 + m * 16;
#pragma unroll
                    for (int bj = 0; bj < 2; ++bj) {
                        const f32x4 v0 = acc[ai][bj][m][0], v1 = acc[ai][bj][m][1];
                        u32x4 w; w.x = pk_f16(v0[0], v0[1]); w.y = pk_f16(v0[2], v0[3]); w.z = pk_f16(v1[0], v1[1]); w.w = pk_f16(v1[2], v1[3]);
                        *(u32x4*)(dstb + (size_t)row * 1024 + u.pn * 256 + cl0 + bj * 128) = w;
                    }
                }
        } else if (KSET == 1) {
            f16* dstb = (f16*)(ws + WS_GU);
#pragma unroll
            for (int ai = 0; ai < 2; ++ai)
#pragma unroll
                for (int m = 0; m < 4; ++m) {
                    const int row = rbase + ai * 128 + m * 16;
#pragma unroll
                    for (int bj = 0; bj < 2; ++bj) {
                        const f32x4 v0 = acc[ai][bj][m][0], v1 = acc[ai][bj][m][1];
                        u32x4 w; w.x = pk_f16(v0[0], v0[1]); w.y = pk_f16(v0[2], v0[3]); w.z = pk_f16(v1[0], v1[1]); w.w = pk_f16(v1[2], v1[3]);
                        *(u32x4*)(dstb + (size_t)row * 3072 + u.aux * 1024 + u.pn * 256 + cl0 + bj * 128) = w;
                    }
                }
        } else if (KSET == 2) {
            const f16* ub = (const f16*)(ws + WS_GU); f16* mg = (f16*)(ws + WS_MG);
#pragma unroll
            for (int ai = 0; ai < 2; ++ai)
#pragma unroll
                for (int m = 0; m < 4; ++m) {
                    const int row = rbase + ai * 128 + m * 16;
                    const float rs = rtab[ai * 128 + wr * 64 + m * 16 + fr];
#pragma unroll
                    for (int bj = 0; bj < 2; ++bj) {
                        const int col = u.pn * 256 + cl0 + bj * 128;
                        const f16x8 uo = *(const f16x8*)(ub + (size_t)row * 3072 + u.aux * 1024 + col);
                        f16* mp = mg + (size_t)row * 1024 + col;
                        const f32x4 a0 = acc[ai][bj][m][0] * rs, a1 = acc[ai][bj][m][1] * rs;
                        f32x4 v0, v1;
#pragma unroll
                        for (int j = 0; j < 4; ++j) { v0[j] = sigmoid_f(a0[j]) * (float)uo[j]; v1[j] = sigmoid_f(a1[j]) * (float)uo[4 + j]; }
                        if (u.aux != 0) { const f16x8 pv = *(const f16x8*)mp;
#pragma unroll
                            for (int j = 0; j < 4; ++j) { v0[j] += (float)pv[j]; v1[j] += (float)pv[4 + j]; } }
                        u32x4 w; w.x = pk_f16(v0[0], v0[1]); w.y = pk_f16(v0[2], v0[3]); w.z = pk_f16(v1[0], v1[1]); w.w = pk_f16(v1[2], v1[3]);
                        *(u32x4*)mp = w;
                    }
                }
        } else {
            f16* xh = (f16*)(ws + WS_XH); float* ss = (float*)(ws + WS_SS);
#pragma unroll
            for (int ai = 0; ai < 2; ++ai)
#pragma unroll
                for (int m = 0; m < 4; ++m) {
                    const int row = rbase + ai * 128 + m * 16;
                    float sq = 0.f;
#pragma unroll
                    for (int bj = 0; bj < 2; ++bj) {
                        const size_t off = (size_t)row * DM + u.pn * 256 + cl0 + bj * 128;
                        const f16x8 xb = *(const f16x8*)(xh + off);
                        const f32x4 b0 = {(float)xb[0], (float)xb[1], (float)xb[2], (float)xb[3]}, b1 = {(float)xb[4], (float)xb[5], (float)xb[6], (float)xb[7]};
                        const f32x4 v0 = b0 + acc[ai][bj][m][0], v1 = b1 + acc[ai][bj][m][1];
                        u32x4 w; w.x = pk_f16(v0[0], v0[1]); w.y = pk_f16(v0[2], v0[3]); w.z = pk_f16(v1[0], v1[1]); w.w = pk_f16(v1[2], v1[3]);
                        *(u32x4*)(xh + off) = w;
                        sq += (v0[0] * v0[0] + v0[1] * v0[1]) + (v0[2] * v0[2] + v0[3] * v0[3]) + (v1[0] * v1[0] + v1[1] * v1[1]) + (v1[2] * v1[2] + v1[3] * v1[3]);
                    }
                    sq += xor_lane<16>(sq); { auto rr = __builtin_amdgcn_permlane32_swap(__float_as_uint(sq), __float_as_uint(sq), false, false); sq = __uint_as_float(rr[0]) + __uint_as_float(rr[1]); }
                    if (fq == 0) ss[(size_t)row * 16 + u.pn * 4 + wc] = sq;
                }
        }
    }
};

struct SchedInproj {
    unsigned char* ws; int layer, G, c;
    __device__ __forceinline__ bool next(int i, pg8::Unit& u) const {
        const int L = i * G + c; const int n1 = 64 * 23;
        if (L < n1) { int pm, pn; pg8::tile_of(L, 64, 23, pm, pn);
            u.A = (const char*)(ws + WS_XH) + (size_t)pm * 256 * 2048; u.B = (const char*)(ws + WS_WIN) + ((size_t)layer * NPHYS + (size_t)pn * 256) * 2048;
            u.kind = pg8::K_INPROJ; u.pm = pm; u.pn = pn; u.aux = layer; return true; }
        if (layer != 0) return false;
        const int r = L - n1; if (r >= 32) return false;
        const int l = r >> 3, pm = (r >> 2) & 1, pn = r & 3;
        u.A = (const char*)(ws + WS_MEMN) + (size_t)pm * 256 * 2048; u.B = (const char*)(ws + WS_WMKV) + ((size_t)l * 1024 + (size_t)pn * 256) * 2048;
        u.kind = pg8::K_MEMKV; u.pm = pm; u.pn = pn; u.aux = l; return true;
    }
};
struct SchedUp {
    unsigned char* ws; int layer, G, c;
    __device__ __forceinline__ bool next(int i, pg8::Unit& u) const {
        const int T = (i / 3) * G + c, br = i % 3; if (T >= 64 * 4) return false;
        int pm, pn; pg8::tile_of(T, 64, 4, pm, pn);
        u.A = (const char*)(ws + WS_Y) + ((size_t)pm * 256 * 1536 + br * 512) * 2; u.B = (const char*)(ws + WS_WBR) + (((size_t)layer * 3 + br) * 1024 + (size_t)pn * 256) * 1024;
        u.kind = pg8::K_UP; u.pm = pm; u.pn = pn; u.aux = br; return true;
    }
};
struct SchedMix {
    unsigned char* ws; int layer, G, c;
    __device__ __forceinline__ bool next(int i, pg8::Unit& u) const {
        const int T = (i / 3) * G + c, br = i % 3; if (T >= 64 * 4) return false;
        int pm, pn; pg8::tile_of(T, 64, 4, pm, pn);
        u.A = (const char*)(ws + WS_XH) + (size_t)pm * 256 * 2048; u.B = (const char*)(ws + WS_WMIX) + ((size_t)layer * 3072 + br * 1024 + (size_t)pn * 256) * 2048;
        u.kind = pg8::K_MIX; u.pm = pm; u.pn = pn; u.aux = br; return true;
    }
};
struct SchedOut {
    unsigned char* ws; int layer, G, c;
    __device__ __forceinline__ bool next(int i, pg8::Unit& u) const {
        const int L = i * G + c; if (L >= 256) return false;
        int pm, pn; pg8::tile_of(L, 64, 4, pm, pn);
        u.A = (const char*)(ws + WS_MG) + (size_t)pm * 256 * 2048; u.B = (const char*)(ws + WS_WOUT) + ((size_t)layer * 1024 + (size_t)pn * 256) * 6144;
        u.kind = pg8::K_OUT; u.pm = pm; u.pn = pn; u.aux = layer; return true;
    }
};

template <class ColMap>
__device__ __forceinline__ void convert_w(const float* src, int sld, const float* scale, f16* dst, int N, int K, int dld, int dcol, ColMap cm, LAS float* scr, int lane, int gw, int ngw) {
    const int nblk = N / 32, items = (K / 64) * nblk;
    for (int it = gw; it < items; it += ngw) {
        const int kb = it / nblk, nb = it - kb * nblk, k0 = 64 * kb, n0 = 32 * nb;
        const int col = cm(n0 + (lane & 31));
        float tv[32];
#pragma unroll
        for (int i = 0; i < 32; ++i) { const int kk = 2 * i + (lane >> 5); tv[i] = (col >= 0) ? src[(size_t)(k0 + kk) * sld + col] : 0.f; }
#pragma unroll
        for (int i = 0; i < 32; ++i) { const int kk = 2 * i + (lane >> 5); const float sc = scale ? scale[k0 + kk] : 1.0f; scr[kk * 33 + (lane & 31)] = tv[i] * sc; }
        asm volatile("s_waitcnt lgkmcnt(0)" ::: "memory");
        const int c = lane & 7;
#pragma unroll
        for (int j = 0; j < 4; ++j) { const int n = (lane >> 3) + 8 * j; const LAS float* sp = scr + (8 * c) * 33 + n;
            u32x4 w; w.x = pk_f16(sp[0 * 33], sp[1 * 33]); w.y = pk_f16(sp[2 * 33], sp[3 * 33]); w.z = pk_f16(sp[4 * 33], sp[5 * 33]); w.w = pk_f16(sp[6 * 33], sp[7 * 33]);
            *(u32x4*)(dst + (size_t)(n0 + n) * dld + dcol + k0 + 8 * c) = w; }
        asm volatile("s_waitcnt lgkmcnt(0)" ::: "memory");
    }
}
struct MapIn { __device__ __forceinline__ int operator()(int n) const {
    if (n < 4096) { const int seg = n >> 9, st = seg & 3, p = n & 63; return (st < 2) ? (n - p + unperm64(p)) : n; }
    if (n < 4608) { const int p = n & 63; return L_IQ + (n - 4096) - p + unperm64(p); }
    if (n < 5120) return L_MQ + (n - 4608);
    if (n < 5632) return L_MG + (n - 5120);
    if (n < 5696) return L_IK + unperm64(n - 5632);
    if (n < 5704) return L_IW + (n - 5696);
    return -1; } };
struct MapOff { int off; __device__ __forceinline__ int operator()(int n) const { return off + n; } };

__device__ __forceinline__ void phase_prologue(const Params& P, LAS unsigned char* lds) {
    unsigned char* ws = opaque_ptr(P.ws);
    const int gtid = o_blk() * 512 + opaque_tid(), gthreads = o_grid() * 512;
    const int lane = gtid & 63, gw = gtid >> 6, ngw = gthreads >> 6;
    LAS float* scr = (LAS float*)lds + ((gtid >> 6) & 7) * (64 * 33);
    for (int l = 0; l < DEPTH; ++l) {
        convert_w(P.w_in + (size_t)l * DM * INC, INC, P.norm_g + l * DM, (f16*)(ws + WS_WIN) + (size_t)l * NPHYS * DM, NPHYS, DM, DM, 0, MapIn{}, scr, lane, gw, ngw);
        convert_w(P.w_in + (size_t)l * DM * INC, INC, P.norm_g + l * DM, (f16*)(ws + WS_WMIX) + (size_t)l * 3072 * DM, 3072, DM, DM, 0, MapOff{L_MIX}, scr, lane, gw, ngw);
        convert_w(P.w_mem_kv + (size_t)l * DM * 1024, 1024, P.mem_norm_g + l * DM, (f16*)(ws + WS_WMKV) + (size_t)l * 1024 * DM, 1024, DM, DM, 0, MapOff{0}, scr, lane, gw, ngw);
        for (int n = 0; n < 3; ++n)
            convert_w(P.w_branch + ((size_t)l * 3 + n) * 512 * DM, DM, nullptr, (f16*)(ws + WS_WBR) + ((size_t)l * 3 + n) * 1024 * 512, 1024, 512, 512, 0, MapOff{0}, scr, lane, gw, ngw);
        convert_w(P.w_out + (size_t)l * DM * DM, DM, nullptr, (f16*)(ws + WS_WOUT) + (size_t)l * 1024 * 3072, 1024, DM, 3072, 0, MapOff{0}, scr, lane, gw, ngw);
    }
    for (int r = gw; r < M; r += ngw) {
        const f32x4* xr = (const f32x4*)(P.x + (size_t)r * DM) + lane; float s = 0.f;
        u32x2* o = (u32x2*)((f16*)(ws + WS_XH) + (size_t)r * DM) + lane;
#pragma unroll
        for (int j = 0; j < 4; ++j) { const f32x4 v = xr[64 * j]; s += (v[0] * v[0] + v[1] * v[1]) + (v[2] * v[2] + v[3] * v[3]); u32x2 w; w.x = pk_f16(v[0], v[1]); w.y = pk_f16(v[2], v[3]); o[64 * j] = w; }
        s = wave_sum(s);
        if (lane < 16) ((float*)(ws + WS_SS))[(size_t)r * 16 + lane] = (lane == 0) ? s : 0.f;
    }
    for (int r = gw; r < BATCH * NMEM; r += ngw) {
        const f32x4* xr = (const f32x4*)(P.mem + (size_t)r * DM) + lane; float s = 0.f; f32x4 v[4];
#pragma unroll
        for (int j = 0; j < 4; ++j) { v[j] = xr[64 * j]; s += (v[j][0] * v[j][0] + v[j][1] * v[j][1]) + (v[j][2] * v[j][2] + v[j][3] * v[j][3]); }
        const float rs = __builtin_amdgcn_rsqf(wave_sum(s) * (1.0f / DM) + RMS_EPS);
        u32x2* o = (u32x2*)((f16*)(ws + WS_MEMN) + (size_t)r * DM) + lane;
#pragma unroll
        for (int j = 0; j < 4; ++j) { u32x2 w; w.x = pk_f16(v[j][0] * rs, v[j][1] * rs); w.y = pk_f16(v[j][2] * rs, v[j][3] * rs); o[64 * j] = w; }
    }
    for (int it = gtid; it < SEQ * 8; it += gthreads) {
        const int pos = it >> 3, i = it & 7;
        const float inv = powf(500000.0f, -(float)i / 8.0f);
        const float ang = (float)pos * inv;
        float sn, cs; sincosf(ang, &sn, &cs);
        ((f32x2*)(ws + WS_ROPE))[it] = (f32x2){cs, sn};
    }
}


__device__ __forceinline__ void phase_memattn(const Params& P, int layer, LAS unsigned char* lds) {
    typedef float f32x16 __attribute__((ext_vector_type(16)));
    typedef short s16x4 __attribute__((ext_vector_type(4)));
    typedef short s16x8 __attribute__((ext_vector_type(8)));
    unsigned char* ws = opaque_ptr(P.ws);
    const int tid = opaque_tid(), lane = tid & 63, wid = tid >> 6, r32 = lane & 31, hi = lane >> 5;
    const f16* QM = (const f16*)(ws + WS_QM); const f16* KV = (const f16*)(ws + WS_KVM) + (size_t)layer * 512 * 1024;
    const f16* G = (const f16*)(ws + WS_G); f16* Y = (f16*)(ws + WS_Y);
    LAS unsigned char* kl = lds;
    LAS unsigned char* vl = lds + 65536;
    LAS float* wsf = (LAS float*)(lds + 131072) + wid * 64;
    const int G_ = o_grid();
    for (int u = o_blk(); u < 256; u += G_) {
        const int qb = u & 31, bh = u >> 5, b = bh >> 2, h = bh & 3;
        __syncthreads();
#pragma unroll
        for (int i = 0; i < 8; ++i) { const int p = tid + 512 * i;
            { const int row = p & 255, chunk = p >> 8; *(LAS u32x4*)(kl + chunk * 4096 + row * 16) = *(const u32x4*)(KV + (size_t)(b * 256 + row) * 1024 + h * 128 + chunk * 8); }
            { const int d0 = p >> 10, kv = (p >> 2) & 255, pc = p & 3; *(LAS u32x4*)(vl + p * 16) = *(const u32x4*)(KV + (size_t)(b * 256 + kv) * 1024 + 512 + h * 128 + d0 * 32 + pc * 8); } }
        const size_t row0 = (size_t)b * SEQ + qb * 256 + wid * 32;
        f16x8 qr[8];
#pragma unroll
        for (int ks = 0; ks < 8; ++ks) qr[ks] = *(const f16x8*)(QM + (row0 + r32) * 512 + h * 128 + 16 * ks + 8 * hi);
        __syncthreads();
        f32x16 sc[8];
#pragma unroll
        for (int kg = 0; kg < 8; ++kg) { f32x16 a;
#pragma unroll
            for (int ks = 0; ks < 8; ++ks) { const f16x8 kf = *(const LAS f16x8*)(kl + (2 * ks + hi) * 4096 + (32 * kg + r32) * 16);
                a = (ks == 0) ? __builtin_amdgcn_mfma_f32_32x32x16_f16(kf, qr[ks], (f32x16){0.f, 0.f, 0.f, 0.f, 0.f, 0.f, 0.f, 0.f, 0.f, 0.f, 0.f, 0.f, 0.f, 0.f, 0.f, 0.f}, 0, 0, 0)
                              : __builtin_amdgcn_mfma_f32_32x32x16_f16(kf, qr[ks], a, 0, 0, 0); }
            sc[kg] = a; __builtin_amdgcn_sched_barrier(0); }
        float mx = sc[0][0];
#pragma unroll
        for (int kg = 0; kg < 8; ++kg)
#pragma unroll
            for (int r = 0; r < 16; ++r) mx = fmaxf(mx, sc[kg][r]);
        { auto rr = __builtin_amdgcn_permlane32_swap(__float_as_uint(mx), __float_as_uint(mx), false, false); mx = fmaxf(__uint_as_float(rr[0]), __uint_as_float(rr[1])); }
        float l = 0.f; u32x4 pw[8][2];
#pragma unroll
        for (int kg = 0; kg < 8; ++kg) {
#pragma unroll
            for (int r = 0; r < 16; ++r) { const float p = __builtin_amdgcn_exp2f(sc[kg][r] - mx); sc[kg][r] = p; l += p; }
#pragma unroll
            for (int s2 = 0; s2 < 2; ++s2) { pw[kg][s2].x = pk_f16(sc[kg][8 * s2 + 0], sc[kg][8 * s2 + 1]); pw[kg][s2].y = pk_f16(sc[kg][8 * s2 + 2], sc[kg][8 * s2 + 3]);
                                            pw[kg][s2].z = pk_f16(sc[kg][8 * s2 + 4], sc[kg][8 * s2 + 5]); pw[kg][s2].w = pk_f16(sc[kg][8 * s2 + 6], sc[kg][8 * s2 + 7]); }
            __builtin_amdgcn_sched_barrier(0);
        }
        { auto rr = __builtin_amdgcn_permlane32_swap(__float_as_uint(l), __float_as_uint(l), false, false); l = __uint_as_float(rr[0]) + __uint_as_float(rr[1]); }
        f32x16 o[4];
#pragma unroll
        for (int d0 = 0; d0 < 4; ++d0) o[d0] = (f32x16){0.f, 0.f, 0.f, 0.f, 0.f, 0.f, 0.f, 0.f, 0.f, 0.f, 0.f, 0.f, 0.f, 0.f, 0.f, 0.f};
        const LAS unsigned char* vb = vl + (4 * hi + ((lane & 15) >> 2)) * 64 + ((lane >> 4) & 1) * 32 + (lane & 3) * 8;
#pragma unroll
        for (int kg = 0; kg < 8; ++kg)
#pragma unroll
            for (int s2 = 0; s2 < 2; ++s2) {
                const f16x8 pa = __builtin_bit_cast(f16x8, pw[kg][s2]);
#pragma unroll
                for (int d0 = 0; d0 < 4; ++d0) {
                    const LAS unsigned char* va = vb + d0 * 16384 + (32 * kg + 16 * s2) * 64;
                    const s16x4 lo = __builtin_bit_cast(s16x4, __builtin_amdgcn_ds_read_tr16_b64_v4i16((LAS s16x4*)va));
                    const s16x4 hh = __builtin_bit_cast(s16x4, __builtin_amdgcn_ds_read_tr16_b64_v4i16((LAS s16x4*)(va + 512)));
                    const s16x8 vv = {lo[0], lo[1], lo[2], lo[3], hh[0], hh[1], hh[2], hh[3]};
                    o[d0] = __builtin_amdgcn_mfma_f32_32x32x16_f16(pa, __builtin_bit_cast(f16x8, vv), o[d0], 0, 0, 0);
                }
                __builtin_amdgcn_sched_barrier(0);
            }
        if (hi == 0) wsf[r32] = l;
        __syncthreads();
        float rli[16];
#pragma unroll
        for (int r = 0; r < 16; ++r) rli[r] = __builtin_amdgcn_rcpf(wsf[(r & 3) + 8 * (r >> 2) + 4 * hi]);
        LAS f16* stg = (LAS f16*)(kl + wid * 8192);
#pragma unroll
        for (int r = 0; r < 16; ++r) { const int orow = (r & 3) + 8 * (r >> 2) + 4 * hi;
#pragma unroll
            for (int d0 = 0; d0 < 4; ++d0) stg[orow * 128 + d0 * 32 + r32] = (f16)(o[d0][r] * rli[r]); }
        asm volatile("s_waitcnt lgkmcnt(0)" ::: "memory");
#pragma unroll
        for (int i = 0; i < 8; ++i) { const int pc = lane + 64 * i, row = pc >> 4, ch = pc & 15;
            const f16x8 ov = *(const LAS f16x8*)(stg + row * 128 + ch * 8);
            const size_t go = (row0 + row) * 1536 + 1024 + h * 128 + ch * 8;
            const f16x8 gv = *(const f16x8*)(G + go);
            u32x4 w; w.x = pk_f16((float)ov[0] * (float)gv[0], (float)ov[1] * (float)gv[1]); w.y = pk_f16((float)ov[2] * (float)gv[2], (float)ov[3] * (float)gv[3]);
            w.z = pk_f16((float)ov[4] * (float)gv[4], (float)ov[5] * (float)gv[5]); w.w = pk_f16((float)ov[6] * (float)gv[6], (float)ov[7] * (float)gv[7]);
            *(u32x4*)(Y + go) = w; }
    }
}

#ifndef IDX_SETUP
#define IDX_SETUP 2
#endif
__device__ __forceinline__ float relu_bits(float x) { const int b = __builtin_bit_cast(int, x); return __builtin_bit_cast(float, b > 0 ? b : 0); }
__device__ __forceinline__ void phase_index(const Params& P, int chunk, LAS unsigned char* lds) {
    typedef float f32x16 __attribute__((ext_vector_type(16)));
    unsigned char* ws = opaque_ptr(P.ws); const int tid = opaque_tid(), lane = tid & 63, wid = tid >> 6, n = lane & 31, kh = lane >> 5;
    const f16* QI = (const f16*)(ws + WS_QI); const f16* KI = (const f16*)(ws + WS_KI); const float* WI = (const float*)(ws + WS_WI); float* SC = (float*)(ws + WS_SC);
    const int ta = ch_t(chunk), tb = ch_t(chunk + 1), nrows = tb - ta, nqb = nrows >> 7;
    const int i0 = ta >> 7;
    const int Wb = (i0 + nqb) * (i0 + nqb + 1) - i0 * (i0 + 1) + IDX_SETUP * nqb, W = 2 * Wb;
    LAS float* wl = (LAS float*)lds;
    LAS unsigned char* kb = lds + 4096;
    LAS unsigned* tbuf = (LAS unsigned*)(lds + 40960) + (tid >> 6) * 576;
    const int G_ = o_grid(), c_ = o_blk();
    int Ls = (int)(((long)c_ * W) / G_); const int Le = (int)(((long)(c_ + 1) * W) / G_);
    while (Ls < Le) {
        const int b = Ls >= Wb ? 1 : 0; int v = Ls - b * Wb, qi = 0;
        for (;; ++qi) { const int ns = 2 * (i0 + qi + 1) + IDX_SETUP; if (v < ns) break; v -= ns; }
        int nv = 2 * (i0 + qi + 1) + IDX_SETUP - v; if (nv > Le - Ls) nv = Le - Ls;
        Ls += nv;
        int vs = v - IDX_SETUP, ve = v + nv - IDX_SETUP;
        if (vs < 0) vs = 0;
        if (ve <= vs) continue;
        v = vs;
        const int ntile = ve - vs;
        const int t0 = ta + 128 * qi, sb = v << 6;
        const int tw = t0 + 16 * wid;
        __syncthreads();
        if (tid < 256) { f32x4 w = *(const f32x4*)(WI + (size_t)(b * SEQ + t0) * 8 + tid * 4); w *= 0.125f; *(LAS f32x4*)(wl + tid * 4) = w; }
        f16x8 A[4][4];
        { const int a = n >> 3, hh = (n >> 2) & 1, c = n & 3, head = 4 * (a & 1) + c, tko = 2 * hh + (a >> 1);
#pragma unroll
          for (int g = 0; g < 4; ++g)
#pragma unroll
              for (int ks = 0; ks < 4; ++ks) A[g][ks] = *(const f16x8*)(QI + (size_t)(b * SEQ + tw + 4 * g + tko) * 512 + head * 64 + 16 * ks + 8 * kh); }
        const f16* kg = KI + (size_t)(b * SEQ + sb + (tid & 63)) * 64 + (tid >> 6) * 8;
        u32x4 st = *(const u32x4*)kg;
        *(LAS u32x4*)(kb + (tid >> 6) * 1024 + (tid & 63) * 16) = st;
        __syncthreads();
        const int rpitch = 64 * ((t0 >> 7) + 1);
        unsigned* srow = (unsigned*)SC + (size_t)b * SC_PB + sc_row(tw);
        for (int j = 0; j < ntile; ++j) {
            const bool more = (j + 1 < ntile);
            if (more) st = *(const u32x4*)(kg + (size_t)(j + 1) * 64 * 64);
            if (sb + 64 * j <= tw + 15)
            {
                const LAS unsigned char* kt = kb + (j & 1) * 8192 + kh * 1024 + n * 16;
                f16x8 B[2][4];
#pragma unroll
                for (int half = 0; half < 2; ++half)
#pragma unroll
                    for (int ks = 0; ks < 4; ++ks) B[half][ks] = *(const LAS f16x8*)(kt + ks * 2048 + half * 512);
#define IDX_Z16 (f32x16){0.f, 0.f, 0.f, 0.f, 0.f, 0.f, 0.f, 0.f, 0.f, 0.f, 0.f, 0.f, 0.f, 0.f, 0.f, 0.f}
#define IDX_MF(g, AC) { _Pragma("unroll") for (int half = 0; half < 2; ++half) { \
                        AC[half] = __builtin_amdgcn_mfma_f32_32x32x16_f16(A[g][0], B[half][0], IDX_Z16, 0, 0, 0); \
                        _Pragma("unroll") for (int ks = 1; ks < 4; ++ks) AC[half] = __builtin_amdgcn_mfma_f32_32x32x16_f16(A[g][ks], B[half][ks], AC[half], 0, 0, 0); } \
                      __builtin_amdgcn_sched_barrier(0); }
#define IDX_EP(g, AC) { const LAS f32x4* wp = (const LAS f32x4*)(wl + (16 * wid + 4 * (g) + 2 * kh) * 8); \
                      const f32x4 w0 = wp[0], w1 = wp[1], w2 = wp[2], w3 = wp[3]; float sv[2][2]; \
                      _Pragma("unroll") for (int half = 0; half < 2; ++half) { float s0 = 0.f, s1 = 0.f; \
                        _Pragma("unroll") for (int hh = 0; hh < 4; ++hh) { s0 = __builtin_fmaf(w0[hh], relu_bits(AC[half][hh]), s0); s1 = __builtin_fmaf(w2[hh], relu_bits(AC[half][8 + hh]), s1); } \
                        _Pragma("unroll") for (int hh = 0; hh < 4; ++hh) { s0 = __builtin_fmaf(w1[hh], relu_bits(AC[half][4 + hh]), s0); s1 = __builtin_fmaf(w3[hh], relu_bits(AC[half][12 + hh]), s1); } \
                        sv[half][0] = s0; sv[half][1] = s1; } \
                      tbuf[(4 * (g) + 2 * kh) * 36 + n] = __builtin_bit_cast(unsigned, __builtin_amdgcn_cvt_pknorm_i16(sv[0][0], sv[1][0])); \
                      tbuf[(4 * (g) + 2 * kh + 1) * 36 + n] = __builtin_bit_cast(unsigned, __builtin_amdgcn_cvt_pknorm_i16(sv[0][1], sv[1][1])); \
                      __builtin_amdgcn_sched_barrier(0); }
#define IDX_ST() if (more) *(LAS u32x4*)(kb + ((j + 1) & 1) * 8192 + (tid >> 6) * 1024 + (tid & 63) * 16) = st;
                f32x16 accA[2], accB[2];
                if (wid < 4) {
                    IDX_MF(0, accA) IDX_EP(0, accA) IDX_MF(1, accA) IDX_EP(1, accA) IDX_MF(2, accA) IDX_EP(2, accA) IDX_ST() IDX_MF(3, accA) IDX_EP(3, accA)
                } else {
                    IDX_MF(0, accA) IDX_MF(1, accB) IDX_EP(0, accA) IDX_MF(2, accA) IDX_EP(1, accB) IDX_MF(3, accB) IDX_ST() IDX_EP(2, accA) IDX_EP(3, accB)
                }
                {
                    unsigned* d = srow + (size_t)(lane >> 3) * rpitch + 32 * ((sb >> 6) + j) + 4 * (lane & 7);
                    const u32x4 r0 = *(const LAS u32x4*)(tbuf + (lane >> 3) * 36 + 4 * (lane & 7)), r1 = *(const LAS u32x4*)(tbuf + ((lane >> 3) + 8) * 36 + 4 * (lane & 7));
                    *(u32x4*)d = r0; *(u32x4*)(d + (size_t)8 * rpitch) = r1;
                }
            } else if (more) *(LAS u32x4*)(kb + ((j + 1) & 1) * 8192 + (tid >> 6) * 1024 + (tid & 63) * 16) = st;
            __syncthreads();
        }
    }
}

__device__ __forceinline__ unsigned sortable(float f) { const unsigned u = __builtin_bit_cast(unsigned, f); return (u & 0x80000000u) ? ~u : (u | 0x80000000u); }
template <int W> __device__ __forceinline__ void putw(unsigned& a0l, unsigned& a0h, unsigned& a1l, unsigned& a1h, unsigned lo, unsigned hi) {
    if (W < 64) { asm volatile("v_writelane_b32 %0, %1, %2" : "+v"(a0l) : "s"(lo), "n"(W & 63)); asm volatile("v_writelane_b32 %0, %1, %2" : "+v"(a0h) : "s"(hi), "n"(W & 63)); }
    else { asm volatile("v_writelane_b32 %0, %1, %2" : "+v"(a1l) : "s"(lo), "n"(W & 63)); asm volatile("v_writelane_b32 %0, %1, %2" : "+v"(a1h) : "s"(hi), "n"(W & 63)); }
}
template <int V> struct IntC { static constexpr int value = V; };
template <int J, int N, class F> __device__ __forceinline__ void static_for_pairs(F&& f) { if constexpr (J < N) { f(IntC<J>{}); static_for_pairs<J + 1, N>(f); } }
namespace att { __device__ __forceinline__ void glds16(const void* g, unsigned lds_base); }
template <int NP>
__device__ __forceinline__ void select_row(const LAS unsigned* rbuf, u64* brow, int t, int ln, LAS unsigned* hist, const unsigned* nsrc, unsigned nlds, int ndma) {
    int x[NP];
#pragma unroll
    for (int j = 0; j < NP; ++j) x[j] = (int)rbuf[j * 64 + ln];
    const int kofs = ln + (ln & 32);
#pragma unroll
    for (int j = NP - 16; j < NP; ++j) {
        const int lim = t - 128 * j;
        if (kofs > lim) x[j] = (x[j] & (int)0xFFFF0000) | 0x8000;
        if (kofs + 32 > lim) x[j] = (x[j] & 0xFFFF) | (int)0x80000000;
    }
    asm volatile("s_waitcnt lgkmcnt(0)" ::: "memory");
    for (int q = 0; q < ndma; ++q) att::glds16(nsrc + q * 256 + ln * 4, (unsigned)__builtin_amdgcn_readfirstlane(nlds + q * 1024));
    int tauq = 0, nge = 0; bool exact = false;
    {
        auto scan_find = [&](int want, int& bin, int& above) {
            const u32x4 hv = *(const LAS u32x4*)(hist + (252 - 4 * ln));
            const unsigned tot = (hv.x + hv.y) + (hv.z + hv.w);
            unsigned p = tot;
            p += (unsigned)__builtin_amdgcn_update_dpp(0, (int)p, 0x111, 0xf, 0xf, false); p += (unsigned)__builtin_amdgcn_update_dpp(0, (int)p, 0x112, 0xf, 0xf, false);
            p += (unsigned)__builtin_amdgcn_update_dpp(0, (int)p, 0x114, 0xf, 0xf, false); p += (unsigned)__builtin_amdgcn_update_dpp(0, (int)p, 0x118, 0xf, 0xf, false);
            p += (unsigned)__builtin_amdgcn_update_dpp(0, (int)p, 0x142, 0xa, 0xf, false); p += (unsigned)__builtin_amdgcn_update_dpp(0, (int)p, 0x143, 0xc, 0xf, false);
            const u64 m = __ballot((int)p >= want);
            const int L = __builtin_ctzll(m);
            const int pl = __builtin_amdgcn_readlane((int)p, L), tl = __builtin_amdgcn_readlane((int)tot, L);
            const int h3 = __builtin_amdgcn_readlane((int)hv.w, L), h2 = __builtin_amdgcn_readlane((int)hv.z, L), h1 = __builtin_amdgcn_readlane((int)hv.y, L);
            int ab = pl - tl, b = 255 - 4 * L;
            if (ab + h3 < want) { ab += h3; --b; if (ab + h2 < want) { ab += h2; --b; if (ab + h1 < want) { ab += h1; --b; } } }
            bin = b; above = ab;
        };
        int B1, above1;
        {
            typedef short s16x2 __attribute__((ext_vector_type(2)));
#define SEL_PROBE(STRIDE, OUT, MIDV) do { \
                const unsigned t16_ = (unsigned)((MIDV) << 8) & 0xFFFFu; \
                const s16x2 tau2_ = __builtin_bit_cast(s16x2, t16_ | (t16_ << 16)); \
                s16x2 cn_ = (s16x2){0, 0}; \
                _Pragma("unroll") for (int j = 0; j < NP; j += (STRIDE)) { const s16x2 d_ = __builtin_elementwise_sub_sat(__builtin_bit_cast(s16x2, x[j]), tau2_); cn_ += d_ >> (s16x2){15, 15}; } \
                int c_ = (int)cn_.x + (int)cn_.y; \
                c_ += __builtin_amdgcn_update_dpp(0, c_, 0x111, 0xf, 0xf, false); c_ += __builtin_amdgcn_update_dpp(0, c_, 0x112, 0xf, 0xf, false); \
                c_ += __builtin_amdgcn_update_dpp(0, c_, 0x114, 0xf, 0xf, false); c_ += __builtin_amdgcn_update_dpp(0, c_, 0x118, 0xf, 0xf, false); \
                c_ += __builtin_amdgcn_update_dpp(0, c_, 0x142, 0xa, 0xf, false); c_ += __builtin_amdgcn_update_dpp(0, c_, 0x143, 0xc, 0xf, false); \
                OUT = 128 * (NP / (STRIDE)) + __builtin_amdgcn_readlane(c_, 63); } while (0)
            int g;
            { int slo = -128, shi = 128;
#pragma unroll 1
              for (int it = 0; it < 8; ++it) { const int mid = (slo + shi) >> 1; int ns; SEL_PROBE(4, ns, mid); if (ns >= 64) slo = mid; else shi = mid; }
              g = slo; }
            int lo = -128, hi = 128, chi = 0, step = 1, dir = 0;
#pragma unroll 1
            while (hi - lo > 1) {
                int mid = (lo + hi) >> 1;
                if (g > lo && g < hi) mid = g;
                int nge_; SEL_PROBE(1, nge_, mid);
                const bool ok = nge_ >= 256; const int d_ = ok ? 1 : -1;
                if (ok) lo = mid; else { hi = mid; chi = nge_; }
                if (g < 1000 && (dir == 0 || dir == d_)) { g = mid + d_ * step; if (dir != 0) step *= 2; dir = d_; } else g = 1000;
            }
#undef SEL_PROBE
            B1 = lo + 128; above1 = chi;
        }
        *(LAS u32x4*)(hist + 4 * ln) = (u32x4){0u, 0u, 0u, 0u};
        const int b1 = B1 - 128;
#pragma unroll
        for (int j = 0; j < NP; ++j) {
            if (__builtin_amdgcn_sbfe(x[j], 8, 8) == b1) __hip_atomic_fetch_add(hist + (x[j] & 0xFF), 1u, __ATOMIC_RELAXED, __HIP_MEMORY_SCOPE_WORKGROUP);
            if ((x[j] >> 24) == b1) __hip_atomic_fetch_add(hist + ((x[j] >> 16) & 0xFF), 1u, __ATOMIC_RELAXED, __HIP_MEMORY_SCOPE_WORKGROUP);
        }
        asm volatile("s_waitcnt lgkmcnt(0)" ::: "memory");
        int B2, above2; scan_find(256 - above1, B2, above2);
        const int neq = __builtin_amdgcn_readfirstlane((int)hist[B2]);
        asm volatile("s_waitcnt lgkmcnt(0)" ::: "memory");
        tauq = b1 * 256 + B2; nge = above1 + above2 + neq; exact = (nge == 256);
    }
    const int T = (int)((unsigned)tauq << 16);
    unsigned a0l = 0, a0h = 0, a1l = 0, a1h = 0;
    if (exact) {
        static_for_pairs<0, NP>([&](auto jc) { constexpr int j = decltype(jc)::value;
            const u64 ba = __ballot((int)((unsigned)x[j] << 16) >= T), bb = __ballot(x[j] >= T);
            putw<2 * j>(a0l, a0h, a1l, a1h, (unsigned)ba, (unsigned)bb); putw<2 * j + 1>(a0l, a0h, a1l, a1h, (unsigned)(ba >> 32), (unsigned)(bb >> 32));
            if ((j & 3) == 3) __builtin_amdgcn_sched_barrier(0); });
    } else {
        int tv = tauq; asm volatile("" : "+v"(tv)); const int tq2 = __builtin_amdgcn_readfirstlane(tv);
        int ngt = 0;
#pragma unroll
        for (int j = 0; j < NP; ++j) { ngt += __builtin_popcountll(__ballot(((int)((unsigned)x[j] << 16) >> 16) > tq2)) + __builtin_popcountll(__ballot((x[j] >> 16) > tq2)); if ((j & 3) == 3) __builtin_amdgcn_sched_barrier(0); }
        int need = 256 - ngt;
        int tv3 = tauq; asm volatile("" : "+v"(tv3)); const int tq3 = __builtin_amdgcn_readfirstlane(tv3);
        static_for_pairs<0, NP>([&](auto jc) { constexpr int j = decltype(jc)::value;
            const int lo = (int)((unsigned)x[j] << 16) >> 16, hi = x[j] >> 16;
            const u64 ga = __ballot(lo > tq3), gb = __ballot(hi > tq3), ea = __ballot(lo == tq3), eb = __ballot(hi == tq3);
            u64 gt0 = (ga & 0xFFFFFFFFull) | (gb << 32), gt1 = (ga >> 32) | (gb & 0xFFFFFFFF00000000ull);
            u64 eq0 = (ea & 0xFFFFFFFFull) | (eb << 32), eq1 = (ea >> 32) | (eb & 0xFFFFFFFF00000000ull);
            int ne = __builtin_popcountll(eq0);
            while (ne > need) { eq0 &= ~(1ull << (63 - __builtin_clzll(eq0))); --ne; }
            need -= ne;
            ne = __builtin_popcountll(eq1);
            while (ne > need) { eq1 &= ~(1ull << (63 - __builtin_clzll(eq1))); --ne; }
            need -= ne;
            const u64 w0 = gt0 | eq0, w1 = gt1 | eq1;
            putw<2 * j>(a0l, a0h, a1l, a1h, (unsigned)w0, (unsigned)(w0 >> 32)); putw<2 * j + 1>(a0l, a0h, a1l, a1h, (unsigned)w1, (unsigned)(w1 >> 32));
            __builtin_amdgcn_sched_barrier(0); });
    }
    brow[ln] = ((u64)a0h << 32) | a0l; brow[64 + ln] = ((u64)a1h << 32) | a1l;
}
__device__ __forceinline__ void phase_select(const Params& P, int chunk, LAS unsigned char* lds) {
    unsigned char* ws = opaque_ptr(P.ws); const int tid = opaque_tid(), lane = tid & 63, wv = tid >> 6;
    LAS unsigned* hist = (LAS unsigned*)(lds + 131072 + 8192) + wv * 256;
    const LAS unsigned* rbuf = (const LAS unsigned*)(lds + wv * 16384);
    const unsigned rlds = (unsigned)(uintptr_t)(lds + wv * 16384);
    const int gw = (o_blk() * 512 + tid) >> 6, ngw = (o_grid() * 512) >> 6;
    const unsigned* SC = (const unsigned*)(ws + WS_SC); u64* BITS = (u64*)(ws + WS_BITS);
    const int ta = ch_t(chunk), tb = ch_t(chunk + 1), nrows = tb - ta;
    int r = gw;
    if (r < BATCH * nrows) {
        const int ru = __builtin_amdgcn_readfirstlane(r); const int b = (ru >= nrows) ? 1 : 0, t = ta + ru - b * nrows;
        if (t >= 256) { const unsigned* src = SC + (size_t)b * SC_PB + sc_row(t); const int nd = 4 * ((t >> 11) + 1);
            for (int q = 0; q < nd; ++q) att::glds16(src + q * 256 + lane * 4, (unsigned)__builtin_amdgcn_readfirstlane(rlds + q * 1024)); }
    }
    for (; r < BATCH * nrows; r += ngw) {
        const int ru = __builtin_amdgcn_readfirstlane(r);
        const int b = (ru >= nrows) ? 1 : 0, t = ta + ru - b * nrows, row = b * SEQ + t;
        u64* brow = BITS + (size_t)row * 128;
        int ln = lane; asm volatile("" : "+v"(ln));
        const int rn = ru + ngw; int ndn = 0; const unsigned* nsrc = SC;
        if (rn < BATCH * nrows) { const int bn = (rn >= nrows) ? 1 : 0, tn = ta + rn - bn * nrows; if (tn >= 256) { ndn = 4 * ((tn >> 11) + 1); nsrc = SC + (size_t)bn * SC_PB + sc_row(tn); } }
        if (t < 256) {
            for (int w = ln; w < 128; w += 64) { const int lo = w * 64; u64 v = 0; if (t >= lo + 63) v = ~0ull; else if (t >= lo) v = (2ull << (t - lo)) - 1ull; brow[w] = v; }
            for (int q = 0; q < ndn; ++q) att::glds16(nsrc + q * 256 + ln * 4, (unsigned)__builtin_amdgcn_readfirstlane(rlds + q * 1024));
            continue;
        }
        asm volatile("s_waitcnt vmcnt(0)" ::: "memory");
        const int nq = t >> 11;
        if (nq == 0) select_row<16>(rbuf, brow, t, ln, hist, nsrc, rlds, ndn);
        else if (nq == 1) select_row<32>(rbuf, brow, t, ln, hist, nsrc, rlds, ndn);
        else if (nq == 2) select_row<48>(rbuf, brow, t, ln, hist, nsrc, rlds, ndn);
        else select_row<64>(rbuf, brow, t, ln, hist, nsrc, rlds, ndn);
    }
    asm volatile("s_waitcnt vmcnt(0)" ::: "memory");
}

__device__ __forceinline__ void phase_gate(const Params& P, LAS unsigned char* lds) {
    unsigned char* ws = opaque_ptr(P.ws);
    const int tid = opaque_tid();
    const f16* QA = (const f16*)(ws + WS_QA); const float* KM = (const float*)(ws + WS_KMEAN); unsigned* SEL = (unsigned*)(ws + WS_SEL);
    LAS float* kml = (LAS float*)lds;
    const int G_ = o_grid();
    for (int u = o_blk(); u < 256; u += G_) {
        const int bh = u >> 4, rc = u & 15, b = bh >> 3, h = bh & 7;
        const int t = rc * 512 + tid, row = b * SEQ + t, own = t >> 8;
        __syncthreads();
        { const int n = tid >> 4, c4 = (tid & 15) * 4; *(LAS f32x4*)(kml + n * 64 + c4) = *(const f32x4*)(KM + ((size_t)(b * 32 + n)) * 512 + h * 64 + c4); }
        __syncthreads();
        unsigned selm = 0;
        if (own <= 3) selm = (1u << own) - 1u;
        else {
            f16x8 q[8];
            const f16* qp = QA + (size_t)row * 512 + h * 64;
#pragma unroll
            for (int d = 0; d < 8; ++d) q[d] = *(const f16x8*)(qp + d * 8);
            float g0 = -INFINITY, g1 = -INFINITY, g2 = -INFINITY; int i0 = 0, i1 = 0, i2 = 0;
            for (int n = 0; n < own; ++n) {
                const LAS float* km = kml + n * 64; float a = 0.f;
#pragma unroll
                for (int d = 0; d < 8; ++d) { const f32x4 k0 = *(const LAS f32x4*)(km + d * 8), k1 = *(const LAS f32x4*)(km + d * 8 + 4);
                    a = __builtin_fmaf((float)q[d][0], k0[0], a); a = __builtin_fmaf((float)q[d][1], k0[1], a); a = __builtin_fmaf((float)q[d][2], k0[2], a); a = __builtin_fmaf((float)q[d][3], k0[3], a);
                    a = __builtin_fmaf((float)q[d][4], k1[0], a); a = __builtin_fmaf((float)q[d][5], k1[1], a); a = __builtin_fmaf((float)q[d][6], k1[2], a); a = __builtin_fmaf((float)q[d][7], k1[3], a); }
                if (a > g0) { g2 = g1; i2 = i1; g1 = g0; i1 = i0; g0 = a; i0 = n; }
                else if (a > g1) { g2 = g1; i2 = i1; g1 = a; i1 = n; }
                else if (a > g2) { g2 = a; i2 = n; }
            }
            selm = (1u << i0) | (1u << i1) | (1u << i2);
        }
        SEL[(size_t)row * 8 + h] = selm;
    }
}


namespace att {
typedef float f32x16 __attribute__((ext_vector_type(16)));
typedef short s16x4 __attribute__((ext_vector_type(4)));
typedef short v4i16_t __attribute__((ext_vector_type(4)));
constexpr int QBLK = 32, QB = 256, KVBLK = 64, PITCH = 512;
constexpr int SLOTB = 8192, LDS_K = 0, LDS_V = 3 * SLOTB, LDS_WS = 6 * SLOTB, LDS_OST = LDS_WS + 8 * 256, LDS_BYTES = LDS_OST + 8 * 4096;
constexpr int THR = 8;
#define SBAR() __builtin_amdgcn_sched_barrier(0)
#define PIN(x) asm volatile("" : "+v"(x))
#define MFMA(a, b, c) __builtin_amdgcn_mfma_f32_32x32x16_f16(a, b, c, 0, 0, 0)
#define WAIT_BARW(N) do { asm volatile("s_waitcnt vmcnt(" #N ") lgkmcnt(0)\n\ts_barrier" ::: "memory"); __builtin_amdgcn_sched_barrier(0); asm volatile("" : "+v"(wq)); } while (0)
__device__ __forceinline__ int crow(int r, int hi) { return (r & 3) + 8 * (r >> 2) + 4 * hi; }
__device__ __forceinline__ unsigned cvtpk(float lo, float hi) { return pk_f16(lo, hi); }
__device__ __forceinline__ void glds16(const void* g, unsigned lds_base) {
    unsigned sv; asm volatile("s_mov_b32 %0, m0\n\ts_mov_b32 m0, %2\n\ts_nop 0\n\tglobal_load_lds_dwordx4 %1, off\n\ts_mov_b32 m0, %0" : "=&s"(sv) : "v"(g), "s"(lds_base) : "memory"); }
typedef __attribute__((address_space(3))) const char* lds_cptr;
__device__ __forceinline__ void kload2(f16x8* kf, lds_cptr kp, int d0) { kf[2 * d0] = *(const __attribute__((address_space(3))) f16x8*)(kp + d0 * 2048); kf[2 * d0 + 1] = *(const __attribute__((address_space(3))) f16x8*)(kp + d0 * 2048 + 512); }
__device__ __forceinline__ s16x4 vtr(lds_cptr p) { return __builtin_bit_cast(s16x4, __builtin_amdgcn_ds_read_tr16_b64_v4i16((__attribute__((address_space(3))) v4i16_t*)p)); }
#define MX3(a, b, c) __builtin_fmaxf(__builtin_fmaxf((a), (b)), (c))
__device__ __forceinline__ float rowmax(const f32x16& p0, const f32x16& p1) {
    float a = MX3(p0[0], p0[1], p1[0]), b = MX3(p0[2], p0[3], p1[1]); a = MX3(a, p1[2], p1[3]);
#pragma unroll
    for (int r = 4; r < 16; r += 4) { a = MX3(a, p0[r], p0[r + 1]); b = MX3(b, p0[r + 2], p0[r + 3]); a = MX3(a, p1[r], p1[r + 1]); b = MX3(b, p1[r + 2], p1[r + 3]); }
    float m = __builtin_fmaxf(a, b); auto rr = __builtin_amdgcn_permlane32_swap(__float_as_uint(m), __float_as_uint(m), false, false);
    return __builtin_fmaxf(__uint_as_float(rr[0]), __uint_as_float(rr[1])); }
template <int POS> __device__ __forceinline__ float msk1(float p, unsigned w) { unsigned m; asm("v_bfe_i32 %0, %1, %2, 1" : "=v"(m) : "v"(w), "n"(POS)); return __uint_as_float(__float_as_uint(p) & m); }
#define MSK(P, i, w) P[i] = msk1<((i) & 3) + 8 * ((i) >> 2)>(P[i], (w))

typedef _Float16 h2_t __attribute__((ext_vector_type(2)));
__device__ __forceinline__ unsigned pkadd_h2(unsigned a, unsigned b) { return __builtin_bit_cast(unsigned, (h2_t)(__builtin_bit_cast(h2_t, a) + __builtin_bit_cast(h2_t, b))); }
__device__ __forceinline__ float hsum_h2(unsigned a) { const h2_t v = __builtin_bit_cast(h2_t, a); return (float)v.x + (float)v.y; }
constexpr int LDS_LUT = LDS_BYTES;
__device__ __forceinline__ void glds16s(const void* sbase, unsigned voff, unsigned lds_base) {
    unsigned sv; asm volatile("s_mov_b32 %0, m0\n\ts_mov_b32 m0, %3\n\ts_nop 0\n\tglobal_load_lds_dwordx4 %1, %2\n\ts_mov_b32 m0, %0" : "=&s"(sv) : "v"(voff), "s"(sbase), "s"(lds_base) : "memory"); }
template <int MODE>
__device__ __forceinline__ void attn_unit(int b, int h, int qb, const f16* Q, const f16* __restrict__ K, const f16* __restrict__ V, const f16* G, f16* Y, int coff,
                                          const u64* BITS, const unsigned* SEL, char* lds) {
    const int tid = opaque_tid(), lane = tid & 63, r32 = lane & 31, hi = lane >> 5; const int wid = __builtin_amdgcn_readfirstlane(tid >> 6);
    const long rowbase = (long)b * SEQ; const int q0 = qb * QB, NT = (q0 + QB) / KVBLK;
    const f16* Qw = Q + (rowbase + q0 + wid * QBLK) * PITCH + h * 64;
    const unsigned lds0 = (unsigned)(uintptr_t)lds; float* wsf = (float*)(lds + LDS_WS) + wid * 64;
    const f16* kbase = K + rowbase * PITCH + h * 64; const f16* vbase = V + rowbase * PITCH + h * 64;
    const unsigned koff = (unsigned)(lane * PITCH + wid * 8) * 2u, voff = (unsigned)((16 * (wid & 3) + (lane >> 2)) * PITCH + (wid >> 2) * 32 + (lane & 3) * 8) * 2u;
    const unsigned kdst = lds0 + LDS_K + wid * 1024, vdst = lds0 + LDS_V + wid * 1024;
#define DMA_K(t, slot) glds16s(kbase + (long)(t) * KVBLK * PITCH, koff, (unsigned)__builtin_amdgcn_readfirstlane(kdst + (slot)))
#define DMA_V(t, slot) glds16s(vbase + (long)(t) * KVBLK * PITCH, voff, (unsigned)__builtin_amdgcn_readfirstlane(vdst + (slot)))
    const lds_cptr vp0 = (lds_cptr)lds + LDS_V + ((lane >> 4) & 1) * 32 + (lane & 3) * 8 + (4 * hi + ((lane & 15) >> 2)) * 64;
    const lds_cptr kp0 = (lds_cptr)lds + LDS_K + hi * 1024 + r32 * 16;
    const int tq = q0 + wid * QBLK + r32;
    const u64* wbase = BITS + (size_t)rowbase * 128; const unsigned woff = (unsigned)tq * 1024u;
    unsigned selm = 0; if (MODE == 1) selm = SEL[(size_t)(rowbase + tq) * 8 + h];
    u64 wq = 0; unsigned w8lo = 0, w8hi = 0;
    const lds_cptr lutp = (lds_cptr)lds + LDS_LUT;
    if (tid < 16) { const unsigned a_ = ((tid & 1) ? 0xFFFFu : 0u) | ((tid & 2) ? 0xFFFF0000u : 0u), b_ = ((tid & 4) ? 0xFFFFu : 0u) | ((tid & 8) ? 0xFFFF0000u : 0u);
                    *(u32x2*)(lds + LDS_LUT + tid * 8) = (u32x2){a_, b_}; }
#define LUTRD(w8, g) (*(const __attribute__((address_space(3))) u32x2*)(lutp + __builtin_amdgcn_ubfe((w8), 8 * (g), 8)))
#define MASKP(LM, PW, a, b) do { PW[a] &= LM[0]; PW[b] &= LM[1]; sacc = pkadd_h2(pkadd_h2(sacc, PW[a]), PW[b]); } while (0)
#define WGET(t) do { if (MODE == 0) { asm volatile("global_load_dwordx2 %0, %1, %2" : "=v"(wq) : "v"(woff), "s"(wbase + (t)) : "memory"); } \
                     else { const int blk_ = (t) >> 2; const int d_ = tq - 64 * (t); \
                            const u64 tri_ = d_ >= 63 ? ~0ull : (d_ < 0 ? 0ull : ((2ull << d_) - 1ull)); \
                            wq = (blk_ == qb) ? tri_ : (((selm >> blk_) & 1u) ? ~0ull : 0ull); } } while (0)
#define WSET() do { w8lo = (((unsigned)wq >> (4 * hi)) & 0x0F0F0F0Fu) << 3; w8hi = (((unsigned)(wq >> 32) >> (4 * hi)) & 0x0F0F0F0Fu) << 3; } while (0)
    WGET(0);
    DMA_K(0, 0); DMA_V(0, 0); DMA_K(1, SLOTB);
    f16x8 qr[4];
#pragma unroll
    for (int d0 = 0; d0 < 4; ++d0) qr[d0] = *reinterpret_cast<const f16x8*>(&Qw[(long)r32 * PITCH + d0 * 16 + hi * 8]);
    float mhat = 0.f, l_reg = 0.f; f32x16 o[2]; o[0] = zero16_here(); o[1] = o[0];
    f32x16 negm = o[0]; PIN(negm);
    bool resc = false;
    f32x16 pA0, pA1, pB0, pB1; f16x8 kf[4]; s16x4 vlo[3], vhi[3]; u32x4 pw0, pw1, pw2, pw3;
    int sl_prev = 0, sl_cur = 0, sl_next = SLOTB;
#define ROT() do { sl_prev = sl_cur; sl_cur = sl_next; sl_next = (sl_next == 2 * SLOTB) ? 0 : sl_next + SLOTB; } while (0)
#define EX(v) __builtin_amdgcn_exp2f(v)
#define RESC() do { if (resc) { _Pragma("unroll") for (int d_ = 0; d_ < 2; ++d_) _Pragma("unroll") for (int r = 0; r < 16; ++r) o[d_][r] *= wsf[crow(r, hi)]; } } while (0)
    DMA_K(2, 2 * SLOTB);
    WAIT_BARW(3);
    WSET();
#define KLD(kp, d0) do { kf[2 * ((d0) & 1)] = *(const __attribute__((address_space(3))) f16x8*)((kp) + (d0) * 2048); kf[2 * ((d0) & 1) + 1] = *(const __attribute__((address_space(3))) f16x8*)((kp) + (d0) * 2048 + 512); } while (0)
    KLD(kp0, 0); KLD(kp0, 1);
    pA0 = MFMA(kf[0], qr[0], negm); pA1 = MFMA(kf[1], qr[0], negm); SBAR(); KLD(kp0, 2); pA0 = MFMA(kf[2], qr[1], pA0); pA1 = MFMA(kf[3], qr[1], pA1); SBAR(); KLD(kp0, 3);
    pA0 = MFMA(kf[0], qr[2], pA0); pA1 = MFMA(kf[1], qr[2], pA1); pA0 = MFMA(kf[2], qr[3], pA0); pA1 = MFMA(kf[3], qr[3], pA1);
    { const float rm = rowmax(pA0, pA1); mhat = rm;
#pragma unroll
      for (int r = 0; r < 16; ++r) negm[r] = -mhat;
      PIN(negm);
#pragma unroll
      for (int r = 0; r < 16; ++r) { pA0[r] = EX(pA0[r] - rm); pA1[r] = EX(pA1[r] - rm); } }
    WAIT_BARW(0);
    DMA_K(3, 0); DMA_V(1, SLOTB); ROT();
    KLD(kp0 + sl_cur, 0); KLD(kp0 + sl_cur, 1);
    WAIT_BARW(2);
#define PKW(P, i) cvtpk(P[i], P[i + 1])
#define PAF(k) __builtin_bit_cast(f16x8, pw##k)
#define VFRS(sl_) __builtin_bit_cast(f16x8, (short __attribute__((ext_vector_type(8)))){vlo[sl_][0], vlo[sl_][1], vlo[sl_][2], vlo[sl_][3], vhi[sl_][0], vhi[sl_][1], vhi[sl_][2], vhi[sl_][3]})
#define VRDS(sl_, i) do { vlo[sl_] = vtr(vp_ + (((i) >> 2) * 4096 + ((i) & 3) * 1024)); vhi[sl_] = vtr(vp_ + (((i) >> 2) * 4096 + ((i) & 3) * 1024 + 512)); } while (0)
#define KRD(Gx, d0) do { if (Gx) { KLD(kp0 + sl_next, d0); SBAR(); } } while (0)
#define GAPA(MF, P, i, PWa, PWb, X) do { MF; PWa = PKW(P, i); PWb = PKW(P, (i) + 2); X; PIN(sacc); SBAR(); } while (0)
#define GAPB(MF, X, i, Y) do { MF; X[i] = EX(X[i]); X[i + 1] = EX(X[i + 1]); X[i + 2] = EX(X[i + 2]); X[i + 3] = EX(X[i + 3]); Y; PIN(X); PIN(sacc); SBAR(); } while (0)
#define GAPX(MF, ...) do { MF; __VA_ARGS__; PIN(sacc); SBAR(); } while (0)
#define STEP(C0, C1, P0, P1, t, GK, GV, GL) do { SBAR(); \
    WGET(t);                                                             \
    SBAR(); \
    const lds_cptr vp_ = vp0 + sl_prev; \
    unsigned sacc = 0u; u32x2 lm0, lm1, lm2, lm3, lm4, lm5, lm6, lm7; float fl = 1.0f; \
    GAPA(C0 = MFMA(kf[0], qr[0], negm), P0, 0,  pw0[0], pw0[1], (void)0); \
    GAPA(C1 = MFMA(kf[1], qr[0], negm), P0, 4,  pw0[2], pw0[3], (void)0); \
    GAPA(C0 = MFMA(kf[2], qr[1], C0),    P0, 8,  pw1[0], pw1[1], KLD(kp0 + sl_cur, 2); lm0 = LUTRD(w8lo, 0)); \
    GAPA(C1 = MFMA(kf[3], qr[1], C1),    P0, 12, pw1[2], pw1[3], lm1 = LUTRD(w8lo, 1)); \
    GAPA(C0 = MFMA(kf[0], qr[2], C0),    P1, 0,  pw2[0], pw2[1], KLD(kp0 + sl_cur, 3); MASKP(lm0, pw0, 0, 1); lm2 = LUTRD(w8lo, 2)); \
    GAPA(C1 = MFMA(kf[1], qr[2], C1),    P1, 4,  pw2[2], pw2[3], MASKP(lm1, pw0, 2, 3); lm3 = LUTRD(w8lo, 3)); \
    GAPA(C0 = MFMA(kf[2], qr[3], C0),    P1, 8,  pw3[0], pw3[1], MASKP(lm2, pw1, 0, 1); lm4 = LUTRD(w8hi, 0); VRDS(0, 0)); \
    GAPA(C1 = MFMA(kf[3], qr[3], C1),    P1, 12, pw3[2], pw3[3], MASKP(lm3, pw1, 2, 3); lm5 = LUTRD(w8hi, 1); VRDS(1, 4)); \
    if (GK) DMA_K((t) + 3, sl_cur); if (GV) DMA_V((t) + 1, sl_next); \
      \
    float ra_, rb_; \
    GAPX(o[0] = MFMA(PAF(0), VFRS(0), o[0]), ra_ = MX3(C0[0], C0[1], C0[2]); rb_ = MX3(C0[3], C0[4], C0[5]); ra_ = MX3(ra_, C0[6], C0[7]); rb_ = MX3(rb_, C0[8], C0[9]); ra_ = MX3(ra_, C0[10], C0[11]); rb_ = MX3(rb_, C0[12], C0[13]); ra_ = MX3(ra_, C0[14], C0[15]); \
         MASKP(lm4, pw2, 0, 1); lm6 = LUTRD(w8hi, 2); VRDS(2, 1); PIN(ra_); PIN(rb_)); \
    GAPX(o[1] = MFMA(PAF(0), VFRS(1), o[1]), ra_ = MX3(ra_, C1[0], C1[1]); rb_ = MX3(rb_, C1[2], C1[3]); ra_ = MX3(ra_, C1[4], C1[5]); rb_ = MX3(rb_, C1[6], C1[7]); ra_ = MX3(ra_, C1[8], C1[9]); rb_ = MX3(rb_, C1[10], C1[11]); ra_ = MX3(ra_, C1[12], C1[13]); rb_ = MX3(rb_, C1[14], C1[15]); \
         MASKP(lm5, pw2, 2, 3); lm7 = LUTRD(w8hi, 3); VRDS(0, 5); PIN(ra_); PIN(rb_)); \
    { float rm = __builtin_fmaxf(ra_, rb_); { auto rr_ = __builtin_amdgcn_permlane32_swap(__float_as_uint(rm), __float_as_uint(rm), false, false); rm = __builtin_fmaxf(__uint_as_float(rr_[0]), __uint_as_float(rr_[1])); } \
      resc = false;                                                                     \
      if (__builtin_expect(__any(rm > (float)THR), 0)) { const float dl = __builtin_fmaxf(rm, 0.f); mhat += dl; \
          _Pragma("unroll") for (int r = 0; r < 16; ++r) { C0[r] -= dl; C1[r] -= dl; } \
          _Pragma("unroll") for (int r = 0; r < 16; ++r) negm[r] = -mhat; \
          PIN(negm); \
          const float f = __builtin_amdgcn_exp2f(-dl); l_reg *= f; fl = f; if (hi == 0) wsf[r32] = f; resc = true; } } \
    SBAR(); \
    KRD(GL, 0); GAPX(o[0] = MFMA(PAF(1), VFRS(2), o[0]), C0[0] = EX(C0[0]); C0[1] = EX(C0[1]); C0[2] = EX(C0[2]); C0[3] = EX(C0[3]); C0[4] = EX(C0[4]); C0[5] = EX(C0[5]); MASKP(lm6, pw3, 0, 1); VRDS(1, 2); PIN(C0)); \
    KRD(GL, 1); GAPX(o[1] = MFMA(PAF(1), VFRS(0), o[1]), C0[6] = EX(C0[6]); C0[7] = EX(C0[7]); C0[8] = EX(C0[8]); C0[9] = EX(C0[9]); C0[10] = EX(C0[10]); C0[11] = EX(C0[11]); MASKP(lm7, pw3, 2, 3); VRDS(2, 6); PIN(C0)); \
    GAPX(o[0] = MFMA(PAF(2), VFRS(1), o[0]), C0[12] = EX(C0[12]); C0[13] = EX(C0[13]); C0[14] = EX(C0[14]); C0[15] = EX(C0[15]); C1[0] = EX(C1[0]); VRDS(0, 3); PIN(C0); PIN(C1)); \
    GAPX(o[1] = MFMA(PAF(2), VFRS(2), o[1]), C1[1] = EX(C1[1]); C1[2] = EX(C1[2]); C1[3] = EX(C1[3]); C1[4] = EX(C1[4]); C1[5] = EX(C1[5]); VRDS(1, 7); PIN(C1)); \
    l_reg += hsum_h2(sacc) * fl;                                         \
    GAPX(o[0] = MFMA(PAF(3), VFRS(0), o[0]), C1[6] = EX(C1[6]); C1[7] = EX(C1[7]); C1[8] = EX(C1[8]); C1[9] = EX(C1[9]); C1[10] = EX(C1[10]); PIN(C1)); \
    GAPX(o[1] = MFMA(PAF(3), VFRS(1), o[1]), C1[11] = EX(C1[11]); C1[12] = EX(C1[12]); C1[13] = EX(C1[13]); C1[14] = EX(C1[14]); C1[15] = EX(C1[15]); PIN(C1)); \
    } while (0)
    int t = 1;
    for (; t + 5 < NT; t += 2) {
        STEP(pB0, pB1, pA0, pA1, t, true, true, true);     WAIT_BARW(2); WSET(); RESC(); ROT();
        STEP(pA0, pA1, pB0, pB1, t + 1, true, true, true); WAIT_BARW(2); WSET(); RESC(); ROT();
    }
#define ENDW(tt) do { if ((tt) + 3 < NT) { WAIT_BARW(2); } else if ((tt) + 2 < NT) { WAIT_BARW(1); } else { WAIT_BARW(0); } } while (0)
    for (; t + 1 < NT; t += 2) {
        STEP(pB0, pB1, pA0, pA1, t, (t + 3 < NT), (t + 1 < NT), (t + 1 < NT));         ENDW(t);     WSET(); RESC(); ROT();
        STEP(pA0, pA1, pB0, pB1, t + 1, (t + 4 < NT), (t + 2 < NT), (t + 2 < NT));     ENDW(t + 1); WSET(); RESC(); ROT();
    }
    STEP(pB0, pB1, pA0, pA1, NT - 1, false, false, false);
    asm volatile("s_waitcnt vmcnt(0)" ::: "memory"); __builtin_amdgcn_sched_barrier(0); asm volatile("" : "+v"(wq));
    WSET(); RESC();
    {
      pw0 = (u32x4){PKW(pB0, 0), PKW(pB0, 2), PKW(pB0, 4), PKW(pB0, 6)}; pw1 = (u32x4){PKW(pB0, 8), PKW(pB0, 10), PKW(pB0, 12), PKW(pB0, 14)};
      pw2 = (u32x4){PKW(pB1, 0), PKW(pB1, 2), PKW(pB1, 4), PKW(pB1, 6)}; pw3 = (u32x4){PKW(pB1, 8), PKW(pB1, 10), PKW(pB1, 12), PKW(pB1, 14)};
      unsigned sacc = 0u;
      { const u32x2 l0 = LUTRD(w8lo, 0), l1 = LUTRD(w8lo, 1), l2 = LUTRD(w8lo, 2), l3 = LUTRD(w8lo, 3), l4 = LUTRD(w8hi, 0), l5 = LUTRD(w8hi, 1), l6 = LUTRD(w8hi, 2), l7 = LUTRD(w8hi, 3);
        MASKP(l0, pw0, 0, 1); MASKP(l1, pw0, 2, 3); MASKP(l2, pw1, 0, 1); MASKP(l3, pw1, 2, 3); MASKP(l4, pw2, 0, 1); MASKP(l5, pw2, 2, 3); MASKP(l6, pw3, 0, 1); MASKP(l7, pw3, 2, 3); }
      l_reg += hsum_h2(sacc);
      const lds_cptr vp_ = vp0 + sl_cur;
      VRDS(0, 0); VRDS(1, 4); VRDS(2, 1);
      o[0] = MFMA(PAF(0), VFRS(0), o[0]); SBAR(); VRDS(0, 5); o[1] = MFMA(PAF(0), VFRS(1), o[1]); SBAR(); VRDS(1, 2); o[0] = MFMA(PAF(1), VFRS(2), o[0]); SBAR(); VRDS(2, 6);
      o[1] = MFMA(PAF(1), VFRS(0), o[1]); SBAR(); VRDS(0, 3); o[0] = MFMA(PAF(2), VFRS(1), o[0]); SBAR(); VRDS(1, 7); o[1] = MFMA(PAF(2), VFRS(2), o[1]); SBAR();
      o[0] = MFMA(PAF(3), VFRS(0), o[0]); o[1] = MFMA(PAF(3), VFRS(1), o[1]); }
    { auto rr = __builtin_amdgcn_permlane32_swap(__float_as_uint(l_reg), __float_as_uint(l_reg), false, false); l_reg = __uint_as_float(rr[0]) + __uint_as_float(rr[1]); }
    if (hi == 0) wsf[32 + r32] = l_reg; asm volatile("s_waitcnt lgkmcnt(0)" ::: "memory");
    float rli[16];
#pragma unroll
    for (int r = 0; r < 16; ++r) rli[r] = __builtin_amdgcn_rcpf(wsf[32 + crow(r, hi)]);
    f16* stg = (f16*)(lds + LDS_OST) + wid * 2048;
#pragma unroll
    for (int r = 0; r < 16; ++r) { const int orow = crow(r, hi);
#pragma unroll
        for (int d0 = 0; d0 < 2; ++d0) stg[orow * 64 + d0 * 32 + r32] = (f16)(o[d0][r] * rli[r]); }
    asm volatile("s_waitcnt lgkmcnt(0)" ::: "memory");
    const size_t yb = (size_t)(rowbase + q0 + wid * QBLK) * 1536 + coff + h * 64;
#pragma unroll
    for (int i = 0; i < 4; ++i) { const int row = i * 8 + (lane >> 3), ch = lane & 7;
        const f16x8 ov = *(const f16x8*)(stg + row * 64 + ch * 8); const f16x8 gv = *(const f16x8*)(G + yb + (size_t)row * 1536 + ch * 8);
        u32x4 w; w.x = pk_f16((float)ov[0] * (float)gv[0], (float)ov[1] * (float)gv[1]); w.y = pk_f16((float)ov[2] * (float)gv[2], (float)ov[3] * (float)gv[3]);
        w.z = pk_f16((float)ov[4] * (float)gv[4], (float)ov[5] * (float)gv[5]); w.w = pk_f16((float)ov[6] * (float)gv[6], (float)ov[7] * (float)gv[7]);
        *(u32x4*)(Y + yb + (size_t)row * 1536 + ch * 8) = w; }
    asm volatile("s_waitcnt lgkmcnt(0)\n\ts_barrier" ::: "memory");
#undef DMA_K
#undef DMA_V
#undef ROT
#undef EX
#undef RESC
#undef PKW
#undef PAF
#undef VFRS
#undef VRDS
#undef KRD
#undef GAPA
#undef GAPB
#undef STEP
#undef ENDW
#undef WGET
#undef WSET
}
constexpr int R_K = 0, R_V = 32768, R_WS = 65536, R_OST = R_WS + 8 * 256, R_Q = R_OST + 8 * 4096, R_DT = R_Q + 8 * 1024, R_END = R_DT + 8 * 128;
template <bool CAUSAL>
__device__ __forceinline__ void moba_item(int rowg, int tloc, unsigned dent, int h, const f16* Q, f16* PO, float* PML, char* lds, int wid, int lane) {
    const int r32 = lane & 31, hi = lane >> 5;
    float* wsf = (float*)(lds + R_WS) + wid * 64;
    unsigned* dtab = (unsigned*)(lds + R_DT) + wid * 32;
    const lds_cptr kp0 = (lds_cptr)lds + R_K + hi * 1024 + r32 * 16;
    const lds_cptr vp0 = (lds_cptr)lds + R_V + ((lane >> 4) & 1) * 32 + (lane & 3) * 8 + (4 * hi + ((lane & 15) >> 2)) * 64;
    if (hi == 0) dtab[r32] = dent;
    f16x8 qr[4];
#pragma unroll
    for (int d0 = 0; d0 < 4; ++d0) qr[d0] = *reinterpret_cast<const f16x8*>(Q + (size_t)rowg * PITCH + h * 64 + d0 * 16 + hi * 8);
    float mhat = 0.f, l_reg = 0.f; f32x16 o[2]; o[0] = zero16_here(); o[1] = o[0];
    f32x16 negm = o[0]; PIN(negm);
    bool resc = false;
    f32x16 pA0, pA1, pB0, pB1; f16x8 kf[8]; s16x4 vlo[8], vhi[8]; u32x4 pw0, pw1, pw2, pw3;
    unsigned mlo = 0, mhi = 0;
#define RW(t) do { if (CAUSAL) { const int d_ = tloc - 64 * (t); const u64 w_ = d_ >= 63 ? ~0ull : (d_ < 0 ? 0ull : ((2ull << d_) - 1ull)); mlo = (unsigned)w_ >> (4 * hi); mhi = (unsigned)(w_ >> 32) >> (4 * hi); } } while (0)
#define EX(v) __builtin_amdgcn_exp2f(v)
#define RESC() do { if (resc) { asm volatile("s_waitcnt lgkmcnt(0)" ::: "memory"); _Pragma("unroll") for (int d_ = 0; d_ < 2; ++d_) _Pragma("unroll") for (int r = 0; r < 16; ++r) o[d_][r] *= wsf[crow(r, hi)]; } } while (0)
    _Pragma("unroll") for (int d0 = 0; d0 < 4; ++d0) kload2(kf, kp0, d0);
    pA0 = MFMA(kf[0], qr[0], negm); pA1 = MFMA(kf[1], qr[0], negm); pA0 = MFMA(kf[2], qr[1], pA0); pA1 = MFMA(kf[3], qr[1], pA1);
    pA0 = MFMA(kf[4], qr[2], pA0); pA1 = MFMA(kf[5], qr[2], pA1); pA0 = MFMA(kf[6], qr[3], pA0); pA1 = MFMA(kf[7], qr[3], pA1);
    { const float rm = rowmax(pA0, pA1); mhat = rm;
#pragma unroll
      for (int r = 0; r < 16; ++r) negm[r] = -mhat;
      PIN(negm);
#pragma unroll
      for (int r = 0; r < 16; ++r) { pA0[r] = EX(pA0[r] - rm); pA1[r] = EX(pA1[r] - rm); } }
    _Pragma("unroll") for (int d0 = 0; d0 < 4; ++d0) kload2(kf, kp0 + 8192, d0);
#define PKW(P, i) cvtpk(P[i], P[i + 1])
#define PAF(k) __builtin_bit_cast(f16x8, pw##k)
#define VFR(i) __builtin_bit_cast(f16x8, (short __attribute__((ext_vector_type(8)))){vlo[i][0], vlo[i][1], vlo[i][2], vlo[i][3], vhi[i][0], vhi[i][1], vhi[i][2], vhi[i][3]})
#define VRD(i) do { vlo[i] = vtr(vp_ + (((i) >> 2) * 4096 + ((i) & 3) * 1024)); vhi[i] = vtr(vp_ + (((i) >> 2) * 4096 + ((i) & 3) * 1024 + 512)); } while (0)
#define KRD(Gx, t, d0) do { if (Gx) { kload2(kf, kp0 + ((t) + 1) * 8192, d0); SBAR(); } } while (0)
#define MC(P, i, w) do { if (CAUSAL) { MSK(P, i, w); } } while (0)
#define GAPA(MF, M0, M1, M2, M3, a0, a1, a2, a3, W0, W1, PW) do { MF; M0; M1; M2; M3; sacc = pkadd_h2(pkadd_h2(sacc, (W0)), (W1)); PIN(PW); PIN(sacc); SBAR(); } while (0)
#define GAPB(MF, X, i) do { MF; X[i] = EX(X[i]); X[i + 1] = EX(X[i + 1]); X[i + 2] = EX(X[i + 2]); X[i + 3] = EX(X[i + 3]); PIN(X); SBAR(); } while (0)
#define RSTEP(C0, C1, P0, P1, t, GL) do { SBAR(); \
    const lds_cptr vp_ = vp0 + ((t) - 1) * 8192; \
    RW((t) - 1); \
    MC(P0, 0, mlo); MC(P0, 1, mlo); \
    VRD(0); SBAR(); unsigned sacc = 0u; \
                    GAPA(C0 = MFMA(kf[0], qr[0], negm), MC(P0, 2, mlo), MC(P0, 3, mlo), MC(P0, 4, mlo), MC(P0, 5, mlo), P0[2], P0[3], P0[4], P0[5],     pw0[0] = PKW(P0, 0),  pw0[1] = PKW(P0, 2),  pw0); \
    VRD(4); SBAR(); GAPA(C1 = MFMA(kf[1], qr[0], negm), MC(P0, 6, mlo), MC(P0, 7, mlo), MC(P0, 8, mlo), MC(P0, 9, mlo), P0[6], P0[7], P0[8], P0[9],     pw0[2] = PKW(P0, 4),  pw0[3] = PKW(P0, 6),  pw0); \
    VRD(1); SBAR(); GAPA(C0 = MFMA(kf[2], qr[1], C0),    MC(P0, 10, mlo), MC(P0, 11, mlo), MC(P0, 12, mlo), MC(P0, 13, mlo), P0[10], P0[11], P0[12], P0[13], pw1[0] = PKW(P0, 8),  pw1[1] = PKW(P0, 10), pw1); \
    VRD(5); SBAR(); GAPA(C1 = MFMA(kf[3], qr[1], C1),    MC(P0, 14, mlo), MC(P0, 15, mlo), MC(P1, 0, mhi), MC(P1, 1, mhi), P0[14], P0[15], P1[0], P1[1],   pw1[2] = PKW(P0, 12), pw1[3] = PKW(P0, 14), pw1); \
    VRD(2); SBAR(); GAPA(C0 = MFMA(kf[4], qr[2], C0),    MC(P1, 2, mhi), MC(P1, 3, mhi), MC(P1, 4, mhi), MC(P1, 5, mhi), P1[2], P1[3], P1[4], P1[5],     pw2[0] = PKW(P1, 0),  pw2[1] = PKW(P1, 2),  pw2); \
    VRD(6); SBAR(); GAPA(C1 = MFMA(kf[5], qr[2], C1),    MC(P1, 6, mhi), MC(P1, 7, mhi), MC(P1, 8, mhi), MC(P1, 9, mhi), P1[6], P1[7], P1[8], P1[9],     pw2[2] = PKW(P1, 4),  pw2[3] = PKW(P1, 6),  pw2); \
    VRD(3); SBAR(); GAPA(C0 = MFMA(kf[6], qr[3], C0),    MC(P1, 10, mhi), MC(P1, 11, mhi), MC(P1, 12, mhi), MC(P1, 13, mhi), P1[10], P1[11], P1[12], P1[13], pw3[0] = PKW(P1, 8),  pw3[1] = PKW(P1, 10), pw3); \
    VRD(7); SBAR(); GAPA(C1 = MFMA(kf[7], qr[3], C1),    MC(P1, 14, mhi), MC(P1, 15, mhi), (void)0, (void)0, P1[14], P1[15], 0.f, 0.f,       pw3[2] = PKW(P1, 12), pw3[3] = PKW(P1, 14), pw3); \
    l_reg += hsum_h2(sacc); \
    { const float rm = rowmax(C0, C1); resc = false; \
      if (__builtin_expect(__any(rm > (float)THR), 0)) { const float dl = __builtin_fmaxf(rm, 0.f); mhat += dl; \
          _Pragma("unroll") for (int r = 0; r < 16; ++r) { C0[r] -= dl; C1[r] -= dl; } \
          _Pragma("unroll") for (int r = 0; r < 16; ++r) negm[r] = -mhat; \
          PIN(negm); \
          const float f = __builtin_amdgcn_exp2f(-dl); l_reg *= f; if (hi == 0) wsf[r32] = f; resc = true; } } \
    SBAR(); \
    GAPB(o[0] = MFMA(PAF(0), VFR(0), o[0]), C0, 0);              GAPB(o[1] = MFMA(PAF(0), VFR(4), o[1]), C0, 4); \
    KRD(GL, t, 0); GAPB(o[0] = MFMA(PAF(1), VFR(1), o[0]), C0, 8);  KRD(GL, t, 1); GAPB(o[1] = MFMA(PAF(1), VFR(5), o[1]), C0, 12); \
    KRD(GL, t, 2); GAPB(o[0] = MFMA(PAF(2), VFR(2), o[0]), C1, 0);  KRD(GL, t, 3); GAPB(o[1] = MFMA(PAF(2), VFR(6), o[1]), C1, 4); \
    GAPB(o[0] = MFMA(PAF(3), VFR(3), o[0]), C1, 8);              GAPB(o[1] = MFMA(PAF(3), VFR(7), o[1]), C1, 12); \
    } while (0)
    RSTEP(pB0, pB1, pA0, pA1, 1, true);  RESC();
    RSTEP(pA0, pA1, pB0, pB1, 2, true);  RESC();
    RSTEP(pB0, pB1, pA0, pA1, 3, false); RESC();
    { RW(3);
      MC(pB0, 0, mlo); MC(pB0, 1, mlo); MC(pB0, 2, mlo); MC(pB0, 3, mlo); MC(pB0, 4, mlo); MC(pB0, 5, mlo); MC(pB0, 6, mlo); MC(pB0, 7, mlo);
      MC(pB0, 8, mlo); MC(pB0, 9, mlo); MC(pB0, 10, mlo); MC(pB0, 11, mlo); MC(pB0, 12, mlo); MC(pB0, 13, mlo); MC(pB0, 14, mlo); MC(pB0, 15, mlo);
      MC(pB1, 0, mhi); MC(pB1, 1, mhi); MC(pB1, 2, mhi); MC(pB1, 3, mhi); MC(pB1, 4, mhi); MC(pB1, 5, mhi); MC(pB1, 6, mhi); MC(pB1, 7, mhi);
      MC(pB1, 8, mhi); MC(pB1, 9, mhi); MC(pB1, 10, mhi); MC(pB1, 11, mhi); MC(pB1, 12, mhi); MC(pB1, 13, mhi); MC(pB1, 14, mhi); MC(pB1, 15, mhi);
      pw0 = (u32x4){PKW(pB0, 0), PKW(pB0, 2), PKW(pB0, 4), PKW(pB0, 6)}; pw1 = (u32x4){PKW(pB0, 8), PKW(pB0, 10), PKW(pB0, 12), PKW(pB0, 14)};
      pw2 = (u32x4){PKW(pB1, 0), PKW(pB1, 2), PKW(pB1, 4), PKW(pB1, 6)}; pw3 = (u32x4){PKW(pB1, 8), PKW(pB1, 10), PKW(pB1, 12), PKW(pB1, 14)};
      unsigned sacc = 0u;
#pragma unroll
      for (int r = 0; r < 4; ++r) sacc = pkadd_h2(pkadd_h2(sacc, pw0[r]), pw1[r]);
#pragma unroll
      for (int r = 0; r < 4; ++r) sacc = pkadd_h2(pkadd_h2(sacc, pw2[r]), pw3[r]);
      l_reg += hsum_h2(sacc);
      const lds_cptr vp_ = vp0 + 3 * 8192; _Pragma("unroll") for (int i = 0; i < 8; ++i) VRD(i);
      o[0] = MFMA(PAF(0), VFR(0), o[0]); o[1] = MFMA(PAF(0), VFR(4), o[1]); o[0] = MFMA(PAF(1), VFR(1), o[0]); o[1] = MFMA(PAF(1), VFR(5), o[1]);
      o[0] = MFMA(PAF(2), VFR(2), o[0]); o[1] = MFMA(PAF(2), VFR(6), o[1]); o[0] = MFMA(PAF(3), VFR(3), o[0]); o[1] = MFMA(PAF(3), VFR(7), o[1]); }
    { auto rr = __builtin_amdgcn_permlane32_swap(__float_as_uint(l_reg), __float_as_uint(l_reg), false, false); l_reg = __uint_as_float(rr[0]) + __uint_as_float(rr[1]); }
    if (hi == 0) { wsf[32 + r32] = l_reg; if (dent != ~0u) { PML[(size_t)dent * 2] = mhat; PML[(size_t)dent * 2 + 1] = l_reg; } }
    asm volatile("s_waitcnt lgkmcnt(0)" ::: "memory");
    float rli[16];
#pragma unroll
    for (int r = 0; r < 16; ++r) rli[r] = __builtin_amdgcn_rcpf(wsf[32 + crow(r, hi)]);
    f16* stg = (f16*)(lds + R_OST) + wid * 2048;
#pragma unroll
    for (int r = 0; r < 16; ++r) { const int orow = crow(r, hi);
#pragma unroll
        for (int d0 = 0; d0 < 2; ++d0) stg[orow * 64 + d0 * 32 + r32] = (f16)(o[d0][r] * rli[r]); }
    asm volatile("s_waitcnt lgkmcnt(0)" ::: "memory");
#pragma unroll
    for (int i = 0; i < 4; ++i) { const int row = i * 8 + (lane >> 3), ch = lane & 7; const unsigned de = dtab[row];
        if (de != ~0u) *(u32x4*)(PO + (size_t)de * 64 + ch * 8) = *(const u32x4*)(stg + row * 64 + ch * 8); }
    asm volatile("s_waitcnt lgkmcnt(0)" ::: "memory");
#undef RW
#undef EX
#undef RESC
#undef PKW
#undef PAF
#undef VFR
#undef VRD
#undef KRD
#undef MC
#undef GAPA
#undef GAPB
#undef RSTEP
}
__device__ __forceinline__ int moba_nseg(int j) { const int n = (7936 - 256 * j + 2047) >> 11; return n < 1 ? 1 : n; }
__device__ __forceinline__ void moba_kv_unit(int bh, int j, const f16* Q, const f16* K, const f16* V, const unsigned* SEL, f16* PO, float* PML, char* lds) {
    const int tid = opaque_tid(), lane = tid & 63, r32 = lane & 31; const int wid = __builtin_amdgcn_readfirstlane(tid >> 6);
    const int b = bh >> 3, h = bh & 7; const long rowbase = (long)b * SEQ;
    const unsigned lds0 = (unsigned)(uintptr_t)lds;
    unsigned* qu = (unsigned*)(lds + R_Q); unsigned* qcnt = (unsigned*)(lds + 131072 + 4096 + 40);
    { const f16* ksrc = K + (rowbase + 256 * j + lane) * PITCH + h * 64 + wid * 8;
      const f16* vsrc = V + (rowbase + 256 * j + 16 * (wid & 3) + (lane >> 2)) * PITCH + h * 64 + (wid >> 2) * 32 + (lane & 3) * 8;
#pragma unroll
      for (int t = 0; t < 4; ++t) { glds16(ksrc + (long)t * 64 * PITCH, (unsigned)__builtin_amdgcn_readfirstlane(lds0 + R_K + t * 8192 + wid * 1024));
                                    glds16(vsrc + (long)t * 64 * PITCH, (unsigned)__builtin_amdgcn_readfirstlane(lds0 + R_V + t * 8192 + wid * 1024)); }
      if (tid == 0) *qcnt = 0u;
      asm volatile("s_waitcnt vmcnt(0) lgkmcnt(0)\n\ts_barrier" ::: "memory"); }
    const int nseg = moba_nseg(j);
#pragma unroll 1
    for (int seg = 0; seg < nseg; ++seg) {
    const int qa = 256 * (j + 1) + 2048 * seg + 256 * wid;
#pragma unroll
    for (int w = 0; w < 4; ++w) {
        const int t = qa + 64 * w + lane;
        const unsigned selm = (t < SEQ) ? SEL[(size_t)(rowbase + t) * 8 + h] : 0u;
        const bool pred = (selm >> j) & 1u;
        const u64 m = __ballot(pred);
        const int n = __builtin_popcountll(m);
        unsigned base = 0u;
        if (n != 0) { if (lane == 0) base = __hip_atomic_fetch_add(qcnt, (unsigned)n, __ATOMIC_RELAXED, __HIP_MEMORY_SCOPE_WORKGROUP); base = (unsigned)__builtin_amdgcn_readfirstlane((int)base); }
        const int pos = (int)base + (int)__builtin_amdgcn_mbcnt_hi((unsigned)(m >> 32), __builtin_amdgcn_mbcnt_lo((unsigned)m, 0u));
        if (pred) qu[pos] = (unsigned)t | ((unsigned)__builtin_popcount(selm & ((1u << j) - 1u)) << 16);
    }
    asm volatile("s_waitcnt lgkmcnt(0)\n\ts_barrier" ::: "memory");
    const int cnt = (int)*(volatile unsigned*)qcnt;
    if (seg == 0) {
        const int tl = 32 * wid + r32; const int rowg = (int)rowbase + 256 * j + tl;
        moba_item<true>(rowg, tl, ((unsigned)rowg * 8u + (unsigned)h) * 4u + 3u, h, Q, PO, PML, lds, wid, lane);
    }
    for (int it = wid; it * 32 < cnt; it += 8) {
        const int e = it * 32 + r32; const unsigned ent = qu[e < cnt ? e : cnt - 1];
        const int rowg = (int)rowbase + (int)(ent & 0xFFFFu);
        const unsigned dent = (e < cnt) ? (((unsigned)rowg * 8u + (unsigned)h) * 4u + (ent >> 16)) : ~0u;
        moba_item<false>(rowg, 0, dent, h, Q, PO, PML, lds, wid, lane);
    }
    if (seg + 1 < nseg) { asm volatile("s_waitcnt lgkmcnt(0)\n\ts_barrier" ::: "memory"); if (tid == 0) *qcnt = 0u; asm volatile("s_waitcnt lgkmcnt(0)\n\ts_barrier" ::: "memory"); }
    }
    asm volatile("s_waitcnt vmcnt(0) lgkmcnt(0)\n\ts_barrier" ::: "memory");
}
#undef SBAR
#undef PIN
#undef MFMA
#undef WAIT_BARW
#undef MX3
#undef MSK
}

template <int MODE>
__device__ __forceinline__ void phase_attn(const Params& P, char* lds) {
    unsigned char* ws = opaque_ptr(P.ws);
    const int G = o_grid(), c = o_blk(), vcu = (G % 8 == 0) ? (c % 8) * (G / 8) + c / 8 : c;
    for (int u = vcu; u < 512; u += G) {
        const int bh = u >> 5, j = u & 31, s = j >> 1, qb = (((j & 1) ^ (u >> 8)) & 1) ? 31 - s : s;
        const int b = bh >> 3, h = bh & 7;
        if (MODE == 0) att::attn_unit<0>(b, h, qb, (const f16*)(ws + WS_QB), (const f16*)(ws + WS_KB), (const f16*)(ws + WS_VB), (const f16*)(ws + WS_G), (f16*)(ws + WS_Y), 512, (const u64*)(ws + WS_BITS), nullptr, lds);
        else att::attn_unit<1>(b, h, qb, (const f16*)(ws + WS_QA), (const f16*)(ws + WS_KA), (const f16*)(ws + WS_VA), (const f16*)(ws + WS_G), (f16*)(ws + WS_Y), 0, nullptr, (const unsigned*)(ws + WS_SEL), lds);
    }
}

constexpr size_t WS_PO = WS_SC;
constexpr size_t WS_PML = WS_SC + 64 * MiB;
constexpr int CW_MOBAQ = 3584;
__device__ __forceinline__ void phase_moba_kv(const Params& P, int layer, char* lds) {
    unsigned char* ws = opaque_ptr(P.ws);
    unsigned* head = (unsigned*)(ws + WS_CTL) + CW_MOBAQ + 64 * layer;
    const int nu = 16 * 32;
    volatile unsigned* nxt = (volatile unsigned*)(lds + 131072 + 4096 + 32);
    for (;;) {
        const int tid = opaque_tid();
        if (tid == 0) *nxt = __hip_atomic_fetch_add(head, 1u, __ATOMIC_RELAXED, __HIP_MEMORY_SCOPE_AGENT);
        __syncthreads();
        int u = (int)*nxt;
        __syncthreads();
        if (u >= nu) break;
        att::moba_kv_unit(u & 15, u >> 4, (const f16*)(ws + WS_QA), (const f16*)(ws + WS_KA), (const f16*)(ws + WS_VA), (const unsigned*)(ws + WS_SEL), (f16*)(ws + WS_PO), (float*)(ws + WS_PML), lds);
    }
}
__device__ __forceinline__ void phase_moba_combine(const Params& P) {
    unsigned char* ws = opaque_ptr(P.ws);
    const int gtid = o_blk() * 512 + opaque_tid(), gthreads = o_grid() * 512;
    const unsigned* SEL = (const unsigned*)(ws + WS_SEL); const f16* PO = (const f16*)(ws + WS_PO); const float* PML = (const float*)(ws + WS_PML);
    const f16* G = (const f16*)(ws + WS_G); f16* Y = (f16*)(ws + WS_Y);
    for (int it = gtid; it < M * 64; it += gthreads) {
        const int ch = it & 7, rh = it >> 3, h = rh & 7, row = rh >> 3;
        const int np = __builtin_popcount(SEL[rh]);
        float mr[4], lw[4]; float mx = -INFINITY;
        const int pvb = __float_as_int(PML[(size_t)rh * 8 + ch]); const int lb4 = ((gtid & 63) & ~7) * 4;
#pragma unroll
        for (int sl = 0; sl < 4; ++sl) { const bool v = (sl == 3) || (sl < np);
            const float m_ = __int_as_float(__builtin_amdgcn_ds_bpermute(lb4 + 8 * sl, pvb)), l_ = __int_as_float(__builtin_amdgcn_ds_bpermute(lb4 + 8 * sl + 4, pvb));
            mr[sl] = v ? m_ : -INFINITY; lw[sl] = v ? l_ : 0.f; mx = fmaxf(mx, mr[sl]); }
        float wsum = 0.f; float acc[8];
#pragma unroll
        for (int k = 0; k < 8; ++k) acc[k] = 0.f;
#pragma unroll
        for (int sl = 0; sl < 4; ++sl) { const bool v = (sl == 3) || (sl < np);
            if (v) { const float w = __builtin_amdgcn_exp2f(mr[sl] - mx) * lw[sl]; wsum += w;
                const f16x8 ov = *(const f16x8*)(PO + ((size_t)rh * 4 + sl) * 64 + ch * 8);
#pragma unroll
                for (int k = 0; k < 8; ++k) acc[k] = __builtin_fmaf(w, (float)ov[k], acc[k]); } }
        const float rw = 1.0f / wsum;
        const size_t go = (size_t)row * 1536 + h * 64 + ch * 8;
        const f16x8 gv = *(const f16x8*)(G + go);
        u32x4 w; w.x = pk_f16(acc[0] * rw * (float)gv[0], acc[1] * rw * (float)gv[1]); w.y = pk_f16(acc[2] * rw * (float)gv[2], acc[3] * rw * (float)gv[3]);
        w.z = pk_f16(acc[4] * rw * (float)gv[4], acc[5] * rw * (float)gv[5]); w.w = pk_f16(acc[6] * rw * (float)gv[6], acc[7] * rw * (float)gv[7]);
        *(u32x4*)(Y + go) = w;
    }
}

__device__ __forceinline__ void phase_final(const Params& P) {
    unsigned char* ws = opaque_ptr(P.ws);
    const int gtid = o_blk() * 512 + opaque_tid(), lane = gtid & 63, gw = gtid >> 6, ngw = (o_grid() * 512) >> 6;
    const f16* xh = (const f16*)(ws + WS_XH); const float* ss = (const float*)(ws + WS_SS);
    for (int r = gw; r < M; r += ngw) {
        const float p = (lane < 16) ? ss[(size_t)r * 16 + lane] : 0.f;
        const float rs = __builtin_amdgcn_rsqf(wave_sum(p) * (1.0f / DM) + RMS_EPS);
        const f16x8* xr = (const f16x8*)(xh + (size_t)r * DM) + lane;
        f32x4* o = (f32x4*)(P.out + (size_t)r * DM) + 2 * lane;
#pragma unroll
        for (int j = 0; j < 2; ++j) { const f16x8 v = xr[64 * j]; const f32x4 g0 = ((const f32x4*)P.final_g)[128 * j + 2 * lane], g1 = ((const f32x4*)P.final_g)[128 * j + 2 * lane + 1];
            o[128 * j] = (f32x4){(float)v[0] * rs * g0[0], (float)v[1] * rs * g0[1], (float)v[2] * rs * g0[2], (float)v[3] * rs * g0[3]};
            o[128 * j + 1] = (f32x4){(float)v[4] * rs * g1[0], (float)v[5] * rs * g1[1], (float)v[6] * rs * g1[2], (float)v[7] * rs * g1[3]}; }
    }
}

#define XB_TMO      128
#define XB_XCNT(j)  (256  + 64 * (j))
#define XB_XSUB(j)  (1280 + 64 * (j))
#define XB_XGEN(j)  (2304 + 64 * (j))
#define XB_TOP      3328
#define XB_TOPGEN   3392
#define XCD_BAR_WORDS 3456
#define XB_SPIN_CAP (1u << 22)
__device__ __forceinline__ unsigned xb_ld(unsigned* p)              { return __hip_atomic_load(p, __ATOMIC_RELAXED, __HIP_MEMORY_SCOPE_AGENT); }
__device__ __forceinline__ unsigned xb_add(unsigned* p, unsigned v) { return __hip_atomic_fetch_add(p, v, __ATOMIC_RELAXED, __HIP_MEMORY_SCOPE_AGENT); }
__device__ __forceinline__ unsigned xb_xcc_id() { return (unsigned)__builtin_amdgcn_s_getreg((3 << 11) | 20) & 0xFu; }
#define XB_SPIN(cond, bar) do { unsigned _sp = 0; while (cond) { __builtin_amdgcn_s_sleep(1); \
    if ((++_sp & 255u) == 0u) { if (xb_ld(&(bar)[XB_TMO])) break; if (_sp > XB_SPIN_CAP) { atomicAdd(&(bar)[XB_TMO], 1u); break; } } } } while (0)
struct XcdBarrier { unsigned* bar; unsigned x; volatile LAS unsigned* st; };
__device__ __forceinline__ XcdBarrier xcd_barrier_post(unsigned* bar, volatile LAS unsigned* st) {
    XcdBarrier b; b.bar = bar; b.x = xb_xcc_id(); b.st = st;
    if (opaque_tid() == 0) (void)xb_add(&bar[XB_XCNT(b.x)], 1u);
    return b;
}
__device__ __forceinline__ void xcd_barrier_complete(unsigned* bar, unsigned x, unsigned& nloc, unsigned& nx) {
    const unsigned G = gridDim.x * gridDim.y * gridDim.z;
    unsigned sum, cnt, mine, sp = 0u;
    for (;;) {
        sum = 0u; cnt = 0u; mine = 0u;
#pragma unroll
        for (unsigned j = 0; j < 16; ++j) { const unsigned c = xb_ld(&bar[XB_XCNT(j)]); sum += c; cnt += (c > 0u) ? 1u : 0u; mine = (j == x) ? c : mine; }
        if (sum == G) break;
        __builtin_amdgcn_s_sleep(1);
        if ((++sp & 255u) == 0u) { if (xb_ld(&bar[XB_TMO])) break; if (sp > XB_SPIN_CAP) { atomicAdd(&bar[XB_TMO], 1u); break; } }
    }
    nloc = mine > 0u ? mine : 1u; nx = cnt > 0u ? cnt : 1u;
}
__device__ __forceinline__ void xcd_barrier(const XcdBarrier& b) {
    asm volatile("s_waitcnt vmcnt(0)" ::: "memory");
    __syncthreads();
    if (opaque_tid() == 0) {
        unsigned* bar = (unsigned*)opaque_ptr((unsigned char*)b.bar);
        __builtin_amdgcn_s_waitcnt(0);
        unsigned bx = b.x; asm volatile("" : "+s"(bx));
        unsigned nloc = b.st[0], nx = b.st[1];
        if (nloc == 0u) { xcd_barrier_complete(bar, bx, nloc, nx); b.st[0] = nloc; b.st[1] = nx; }
        const unsigned old = xb_add(&bar[XB_XSUB(bx)], 1u);
        const unsigned gen = old / nloc;
        if (old + 1u == (gen + 1u) * nloc) {
            __builtin_amdgcn_fence(__ATOMIC_RELEASE, "agent");
            asm volatile("s_waitcnt vmcnt(0)" ::: "memory");
            const unsigned og = xb_add(&bar[XB_TOP], 1u);
            const unsigned tg = og / nx;
            if (og + 1u == (tg + 1u) * nx) xb_add(&bar[XB_TOPGEN], 1u);
            else XB_SPIN(xb_ld(&bar[XB_TOPGEN]) == tg, bar);
            __builtin_amdgcn_fence(__ATOMIC_ACQUIRE, "agent");
            xb_add(&bar[XB_XGEN(bx)], 1u);
            asm volatile("s_waitcnt vmcnt(0)" ::: "memory");
        } else {
            XB_SPIN(xb_ld(&bar[XB_XGEN(bx)]) == gen, bar);
            __builtin_amdgcn_fence(__ATOMIC_ACQUIRE, "agent");
            asm volatile("s_waitcnt vmcnt(0)" ::: "memory");
        }
    }
    __syncthreads();
}


#ifndef REP_PRO
#define REP_PRO 1
#endif
#ifndef REP_INP
#define REP_INP 1
#endif
#ifndef REP_MEM
#define REP_MEM 1
#endif
#ifndef REP_IDX
#define REP_IDX 1
#endif
#ifndef REP_SEL
#define REP_SEL 1
#endif
#ifndef REP_GATE
#define REP_GATE 1
#endif
#ifndef REP_A0
#define REP_A0 1
#endif
#ifndef REP_A1
#define REP_A1 1
#endif
#ifndef REP_MRG
#define REP_MRG 1
#endif
#ifndef REP_OUT
#define REP_OUT 1
#endif
#ifndef REP_FIN
#define REP_FIN 1
#endif
#ifndef REP_BAR
#define REP_BAR 1
#endif
constexpr int LDS_BYTES = 147456;
__global__ void __launch_bounds__(512, 2) trunk_fwd(Params P) {
    extern __shared__ __attribute__((aligned(16))) unsigned char lds_raw[];
    LAS unsigned char* lds = (LAS unsigned char*)lds_raw;
    unsigned* barw = (unsigned*)(P.ws + WS_CTL);
    volatile LAS unsigned* bst = (volatile LAS unsigned*)(lds + 131072 + 4096);
    {
        const unsigned t0 = threadIdx.x;
        const unsigned hw = (unsigned)__builtin_amdgcn_s_getreg((5 << 11) | 4) & 63u;
        if ((t0 & 63u) == 0u) ((volatile LAS unsigned*)(lds + WTAB_OFF))[hw] = t0 >> 6;
        if (t0 < 2) bst[t0] = 0u;
        if (blockIdx.x == 0) for (int i = t0; i < 4096; i += 512) barw[i] = 0u;
        __syncthreads();
    }
    for (int rep = 0; rep < REP_PRO; ++rep) phase_prologue(P, lds);
    cg::this_grid().sync();
    const XcdBarrier bar = xcd_barrier_post(barw, bst);
#define GRID_BAR() do { for (int rep_ = 0; rep_ < REP_BAR; ++rep_) xcd_barrier(bar); } while (0)
    for (int l = 0; l < DEPTH; ++l) {
        for (int rep = 0; rep < REP_INP; ++rep) { unsigned char* wso = opaque_ptr(P.ws); SchedInproj S{wso, l, o_grid(), o_blk()}; Epi<0> E{wso, nullptr, nullptr, l, lds + 131072 + 8192}; pg8::gemm_phase<2048, 2048, 16>(lds, S, E); }
        GRID_BAR();
        for (int rep = 0; rep < REP_MEM; ++rep) phase_memattn(P, l, lds);
        for (int ch = 0; ch < NCHUNK; ++ch) {
            for (int rep = 0; rep < REP_IDX; ++rep) phase_index(P, ch, lds);
            GRID_BAR();
            for (int rep = 0; rep < REP_SEL; ++rep) phase_select(P, ch, lds);
            if (ch == 0) for (int rep = 0; rep < REP_GATE; ++rep) phase_gate(P, lds);
            GRID_BAR();
        }
        for (int rep = 0; rep < REP_A0; ++rep) phase_attn<0>(P, (char*)lds_raw);
        for (int rep = 0; rep < REP_A1; ++rep) phase_moba_kv(P, l, (char*)lds_raw);
        GRID_BAR();
        phase_moba_combine(P);
        GRID_BAR();
        for (int rep = 0; rep < REP_MRG; ++rep) {
            { unsigned char* wso = opaque_ptr(P.ws); SchedUp S{wso, l, o_grid(), o_blk()}; Epi<1> E{wso, nullptr, nullptr, l, lds + 131072 + 8192}; pg8::gemm_phase<3072, 1024, 8>(lds, S, E); }
            { unsigned char* wso = opaque_ptr(P.ws); SchedMix S{wso, l, o_grid(), o_blk()}; Epi<2> E{wso, nullptr, nullptr, l, lds + 131072 + 8192}; pg8::gemm_phase<2048, 2048, 16>(lds, S, E); }
        }
        GRID_BAR();
        for (int rep = 0; rep < (l == 0 ? REP_OUT : 1); ++rep) { unsigned char* wso = opaque_ptr(P.ws); SchedOut S{wso, l, o_grid(), o_blk()}; Epi<3> E{wso, l == 0 ? P.x : P.out, P.out, l, lds + 131072 + 8192}; pg8::gemm_phase<2048, 6144, 16>(lds, S, E); }
        GRID_BAR();
    }
    phase_final(P);
}

extern "C" void kernel_launch(void* const* d_in, const int* in_sizes, int n_in, void* d_out, int out_size, void* d_ws, size_t ws_size, hipStream_t stream) {
    static int grid = 0;
    if (grid == 0) {
        if (n_in != 9 || out_size != M * DM || ws_size < WS_END) { fprintf(stderr, "kernel_launch: unexpected sizes (n_in %d out %d ws %zu need %zu)\n", n_in, out_size, ws_size, (size_t)WS_END); grid = -1; return; }
        int dev = 0, cus = 0, per_cu = 0;
        hipGetDevice(&dev); hipDeviceGetAttribute(&cus, hipDeviceAttributeMultiprocessorCount, dev);
        if (hipFuncSetAttribute((const void*)trunk_fwd, hipFuncAttributeMaxDynamicSharedMemorySize, LDS_BYTES) != hipSuccess) { fprintf(stderr, "kernel_launch: hipFuncSetAttribute failed\n"); grid = -1; return; }
        hipOccupancyMaxActiveBlocksPerMultiprocessor(&per_cu, (const void*)trunk_fwd, 512, LDS_BYTES);
        (void)hipGetLastError();
        if (per_cu < 1) { fprintf(stderr, "kernel_launch: occupancy query says %d blocks per CU\n", per_cu); grid = -1; return; }
        grid = cus;
    }
    if (grid < 0) return;
    Params p{};
    p.x = (const float*)d_in[0]; p.mem = (const float*)d_in[1]; p.norm_g = (const float*)d_in[2]; p.w_in = (const float*)d_in[3]; p.mem_norm_g = (const float*)d_in[4];
    p.w_mem_kv = (const float*)d_in[5]; p.w_branch = (const float*)d_in[6]; p.w_out = (const float*)d_in[7]; p.final_g = (const float*)d_in[8];
    p.out = (float*)d_out; p.ws = (unsigned char*)d_ws;
    void* args[] = {&p};
    hipError_t e = hipLaunchCooperativeKernel((const void*)trunk_fwd, dim3(grid), dim3(512), args, LDS_BYTES, stream);
    if (e != hipSuccess) fprintf(stderr, "kernel_launch: cooperative launch failed: %s (grid %d)\n", hipGetErrorString(e), grid);
}
```

```cpp
#include <hip/hip_runtime.h>
#include <hip/hip_cooperative_groups.h>
#include <cstdio>
#include <cstdint>
namespace cg = cooperative_groups;

#define LAS __attribute__((address_space(3)))
typedef _Float16 f16;
typedef _Float16 f16x8 __attribute__((ext_vector_type(8)));
typedef _Float16 f16x4 __attribute__((ext_vector_type(4)));
typedef _Float16 f16x2 __attribute__((ext_vector_type(2)));
typedef float f32x4 __attribute__((ext_vector_type(4)));
typedef float f32x2 __attribute__((ext_vector_type(2)));
typedef unsigned u32x4 __attribute__((ext_vector_type(4)));
typedef unsigned u32x2 __attribute__((ext_vector_type(2)));
typedef unsigned long long u64;

constexpr int DM = 1024, BATCH = 2, SEQ = 8192, M = BATCH * SEQ, DEPTH = 4;
constexpr int INC = 8776;
constexpr int NPHYS = 5888;
constexpr int NMEM = 256;
constexpr float RMS_EPS = 1e-6f;
constexpr float LOG2E = 1.4426950408889634f;
constexpr float C2_64 = 0.125f * LOG2E;
constexpr float C2_128 = 0.08838834764831845f * LOG2E;
constexpr int L_AQ = 0, L_AK = 512, L_AV = 1024, L_AG = 1536, L_BQ = 2048, L_BK = 2560, L_BV = 3072, L_BG = 3584, L_IQ = 4096, L_IK = 4608, L_IW = 4672, L_MQ = 4680, L_MG = 5192, L_MIX = 5704;

constexpr size_t MiB = 1u << 20;
constexpr size_t WS_CTL = 0;
constexpr size_t WS_WIN = 1 * MiB;
constexpr size_t WS_WMIX = WS_WIN + 46 * MiB;
constexpr size_t WS_WMKV = WS_WMIX + 24 * MiB;
constexpr size_t WS_WBR = WS_WMKV + 8 * MiB;
constexpr size_t WS_WOUT = WS_WBR + 12 * MiB;
constexpr size_t WS_XH = WS_WOUT + 24 * MiB;
constexpr size_t WS_MEMN = WS_XH + 32 * MiB;
constexpr size_t WS_KVM = WS_MEMN + 1 * MiB;
constexpr size_t WS_ROPE = WS_KVM + 4 * MiB;
constexpr size_t WS_KMEAN = WS_ROPE + (MiB / 2);
constexpr size_t WS_SEL = WS_KMEAN + (MiB / 2);
constexpr size_t WS_SS = WS_SEL + (MiB / 2);
constexpr size_t WS_WI = WS_SS + 1 * MiB;
constexpr size_t WS_KI = WS_WI + 1 * MiB;
constexpr size_t WS_BITS = WS_KI + 2 * MiB;
constexpr size_t WS_Y = WS_BITS + 16 * MiB;
constexpr size_t WS_P1 = WS_Y + 48 * MiB;
constexpr size_t WS_QA = WS_P1, WS_KA = WS_QA + 16 * MiB, WS_VA = WS_KA + 16 * MiB, WS_QB = WS_VA + 16 * MiB, WS_KB = WS_QB + 16 * MiB, WS_VB = WS_KB + 16 * MiB,
                 WS_QI = WS_VB + 16 * MiB, WS_QM = WS_QI + 16 * MiB, WS_G = WS_QM + 16 * MiB;
constexpr size_t WS_MG = WS_QI;
constexpr size_t WS_GU = WS_P1;
constexpr size_t WS_SC = WS_G + 48 * MiB;
constexpr size_t WS_END = WS_SC + 131 * MiB;
constexpr int NCHUNK = 1;
__device__ __forceinline__ int ch_t(int c) { return c == 0 ? 0 : 8192; }
constexpr size_t SC_PB = (size_t)4096 * 64 * 65;
__device__ __forceinline__ size_t sc_row(int t) { const int k0 = t >> 7; return (size_t)4096 * k0 * (k0 + 1) + (size_t)64 * (t & 127) * (k0 + 1); }

__device__ __forceinline__ unsigned pk_f16(float lo, float hi) { f32x2 v = {lo, hi}; f16x2 h = __builtin_convertvector(v, f16x2); return __builtin_bit_cast(unsigned, h); }
template <int O> __device__ __forceinline__ float xor_lane(float v) {
    static_assert(O < 32, "xor_lane: inside a 32-lane half only");
    return __uint_as_float((unsigned)__builtin_amdgcn_ds_swizzle((int)__float_as_uint(v), (O << 10) | 0x1F));
}
__device__ __forceinline__ float wave_sum(float v) {
    v += xor_lane<1>(v); v += xor_lane<2>(v); v += xor_lane<4>(v); v += xor_lane<8>(v); v += xor_lane<16>(v);
    { auto rr = __builtin_amdgcn_permlane32_swap(__float_as_uint(v), __float_as_uint(v), false, false); v = __uint_as_float(rr[0]) + __uint_as_float(rr[1]); }
    return v;
}
__device__ __forceinline__ float wave_max(float v) {
    v = fmaxf(v, xor_lane<1>(v)); v = fmaxf(v, xor_lane<2>(v)); v = fmaxf(v, xor_lane<4>(v)); v = fmaxf(v, xor_lane<8>(v)); v = fmaxf(v, xor_lane<16>(v));
    { auto rr = __builtin_amdgcn_permlane32_swap(__float_as_uint(v), __float_as_uint(v), false, false); v = fmaxf(__uint_as_float(rr[0]), __uint_as_float(rr[1])); }
    return v;
}
__device__ __forceinline__ float silu_f(float x) { return x * __builtin_amdgcn_rcpf(1.0f + __builtin_amdgcn_exp2f(-x * LOG2E)); }
__device__ __forceinline__ float sigmoid_f(float x) { return __builtin_amdgcn_rcpf(1.0f + __builtin_amdgcn_exp2f(-x * LOG2E)); }
__host__ __device__ __forceinline__ int unperm64(int p) { return p < 16 ? ((p & 1) ? (p >> 1) + 8 : (p >> 1)) : p; }

constexpr int WTAB_OFF = 131072 + 4096 + 64;
__device__ __forceinline__ int opaque_tid() {
    extern __shared__ __attribute__((aligned(16))) unsigned char lds_dyn_[];
    unsigned hw = (unsigned)__builtin_amdgcn_s_getreg((5 << 11) | 4) & 63u; asm volatile("" : "+s"(hw));
    const unsigned wid = ((volatile LAS unsigned*)((LAS unsigned char*)lds_dyn_ + WTAB_OFF))[hw];
    unsigned lane; asm volatile("v_mbcnt_lo_u32_b32 %0, -1, 0\n\tv_mbcnt_hi_u32_b32 %0, -1, %0" : "=v"(lane));
    return (int)(((unsigned)__builtin_amdgcn_readfirstlane((int)wid) << 6) | lane);
}
typedef float f32x16_t __attribute__((ext_vector_type(16)));
__device__ __forceinline__ f32x16_t zero16_here() { float z; asm volatile("v_mov_b32 %0, 0" : "=v"(z)); f32x16_t r;
#pragma unroll
    for (int i = 0; i < 16; ++i) r[i] = z;
    return r; }
__device__ __forceinline__ unsigned char* opaque_ptr(unsigned char* p) { unsigned long long v = (unsigned long long)p; asm volatile("" : "+s"(v)); return (unsigned char*)(__attribute__((address_space(1))) unsigned char*)v; }
__device__ __forceinline__ int o_grid() { int g = gridDim.x; asm volatile("" : "+s"(g)); return g; }
__device__ __forceinline__ int o_blk() { int b = blockIdx.x; asm volatile("" : "+s"(b)); return b; }
struct Params {
    const float* x; const float* mem; const float* norm_g; const float* w_in; const float* mem_norm_g; const float* w_mem_kv; const float* w_branch; const float* w_out; const float* final_g;
    float* out; unsigned char* ws;
};

namespace pg8 {
constexpr int BM = 256, BK = 64, HALF = 128, HTB = HALF * BK * 2, STAGE_BYTES = 8 * HTB;
__host__ __device__ __forceinline__ int lds_byte(int r, int c) { const int st = (r >> 4) * 2 + (c >> 5), rr = r & 15, cc = c & 31, ob = rr * 64 + cc * 2; return st * 1024 + (ob ^ (((ob >> 9) & 1) << 5)); }
__host__ __device__ __forceinline__ void stage_rc(int b, int& R, int& C) { const int st = b / 1024, sb = b % 1024, swz = sb ^ (((sb >> 9) & 1) << 5); R = (st >> 1) * 16 + swz / 64; C = (st & 1) * 32 + (swz % 64) / 2; }
__host__ __device__ __forceinline__ int perm32(int rho) { const int n = rho >> 4, i = rho & 15; return 8 * (i >> 2) + 4 * n + (i & 3); }

enum Kind { K_INPROJ = 0, K_MEMKV = 1, K_UP = 2, K_MIX = 3, K_OUT = 4 };
struct Unit {
    const char* A; const char* B;
    int kind, pm, pn, aux;
};

template <unsigned LDA2, unsigned LDB2, int NT, class Sched, class Epi>
__device__ __forceinline__ void gemm_phase(LAS unsigned char* lds, const Sched& S, const Epi& E) {
    const int tid = opaque_tid(), wid = __builtin_amdgcn_readfirstlane(tid >> 6), lane = tid & 63, wr = wid >> 2, wc = wid & 3, fr = lane & 15, fq = lane >> 4;
    unsigned RA[2], RB[2], CC[2];
#pragma unroll
    for (int i = 0; i < 2; ++i) { int R, C; stage_rc(tid * 16 + i * 8192, R, C); RA[i] = (unsigned)R; RB[i] = (unsigned)((R & ~31) + perm32(R & 31)); CC[i] = (unsigned)(C * 2); }
    const size_t kstep = (size_t)(BK * 2);
    const unsigned ldsw = (unsigned)wid * 1024u;
    const int aoff = lds_byte(wr * 64 + fr, fq * 8), boff = lds_byte(wc * 32 + fr, fq * 8);
#define PG8_SA(b, h) (((b) * 2 + (h)) * HTB)
#define PG8_SB(b, h) ((4 + (b) * 2 + (h)) * HTB)
#define PG8_STAGE(bufoff, gbase, v0, v1) do { \
        __builtin_amdgcn_global_load_lds((const unsigned*)((const char*)(gbase) + (v0)), (LAS unsigned*)(lds + (bufoff) + ldsw), 16, 0, 0); \
        __builtin_amdgcn_global_load_lds((const unsigned*)((const char*)(gbase) + (v1)), (LAS unsigned*)(lds + (bufoff) + ldsw + 8192), 16, 0, 0); } while (0)
#define PG8_LDA(dst, b, h) do { _Pragma("unroll") for (int m = 0; m < 4; ++m) _Pragma("unroll") for (int k = 0; k < 2; ++k) dst[m][k] = *(const LAS f16x8*)(lds + PG8_SA(b, h) + aoff + m * 2048 + k * 1024); } while (0)
#define PG8_LDB(dst, b, h) do { _Pragma("unroll") for (int n = 0; n < 2; ++n) _Pragma("unroll") for (int k = 0; k < 2; ++k) dst[n][k] = *(const LAS f16x8*)(lds + PG8_SB(b, h) + boff + n * 2048 + k * 1024); } while (0)
#define PG8_MMA(ai, bj, At, Bt) do { __builtin_amdgcn_s_setprio(1); _Pragma("unroll") for (int m = 0; m < 4; ++m) _Pragma("unroll") for (int n = 0; n < 2; ++n) _Pragma("unroll") for (int k = 0; k < 2; ++k) \
        acc[ai][bj][m][n] = __builtin_amdgcn_mfma_f32_16x16x32_f16(Bt[n][k], At[m][k], acc[ai][bj][m][n], 0, 0, 0); __builtin_amdgcn_s_setprio(0); } while (0)
#define PG8_WAIT_V(n) asm volatile("s_waitcnt vmcnt(" #n ")" ::: "memory")
#define PG8_WAIT_L(n) asm volatile("s_waitcnt lgkmcnt(" #n ")" ::: "memory")
#define PG8_BAR __builtin_amdgcn_s_barrier()
#define PG8_SCHED __builtin_amdgcn_sched_barrier(0)
    Unit cur, nxt; int ui = 0;
    if (!S.next(0, cur)) return;
    float pre_cur = E.pre(cur, tid);
    f32x4 acc[2][2][4][2];
#pragma unroll
    for (int a = 0; a < 2; ++a)
#pragma unroll
        for (int b = 0; b < 2; ++b)
#pragma unroll
            for (int m = 0; m < 4; ++m)
#pragma unroll
                for (int n = 0; n < 2; ++n) acc[a][b][m][n] = (f32x4){0.f, 0.f, 0.f, 0.f};
    f16x8 At[4][2], B0[2][2], B1[2][2];
    const char* cA = cur.A; const char* cB = cur.B;
    const unsigned cvA0 = RA[0] * LDA2 + CC[0], cvA1 = RA[1] * LDA2 + CC[1], cvB0 = RB[0] * LDB2 + CC[0], cvB1 = RB[1] * LDB2 + CC[1];
    constexpr size_t chA = (size_t)HALF * LDA2, chB = (size_t)HALF * LDB2;
    PG8_STAGE(PG8_SB(0, 0), cB, cvB0, cvB1); PG8_STAGE(PG8_SB(0, 1), cB + chB, cvB0, cvB1); PG8_STAGE(PG8_SA(0, 0), cA, cvA0, cvA1); PG8_STAGE(PG8_SA(0, 1), cA + chA, cvA0, cvA1);
    if (wr == 1) PG8_BAR;
    PG8_WAIT_V(2); PG8_BAR;
    PG8_STAGE(PG8_SB(1, 0), cB + kstep, cvB0, cvB1); PG8_STAGE(PG8_SA(1, 0), cA + kstep, cvA0, cvA1); PG8_STAGE(PG8_SB(1, 1), cB + chB + kstep, cvB0, cvB1);
    PG8_WAIT_V(6); PG8_BAR;
    for (;;) {
        const bool has_next = S.next(ui + 1, nxt);
        if (!has_next) nxt = cur;
        const char* nA = nxt.A; const char* nB = nxt.B;
        constexpr int nt = NT;
        for (int t = 0; t < nt; t += 2) {
            const bool last = (t == nt - 2);
            const char* a1 = cA + (size_t)(t + 1) * kstep;
            const char* a2 = last ? nA : cA + (size_t)(t + 2) * kstep; const char* b2 = last ? nB : cB + (size_t)(t + 2) * kstep;
            const char* a3 = a2 + kstep; const char* b3 = b2 + kstep;
            const unsigned xA0 = cvA0, xA1 = cvA1, xB0 = cvB0, xB1 = cvB1;
            constexpr size_t xhA = chA, xhB = chB;
            PG8_LDB(B0, 0, 0); PG8_LDB(B1, 0, 1); PG8_SCHED; PG8_LDA(At, 0, 0); PG8_STAGE(PG8_SA(1, 1), a1 + chA, cvA0, cvA1);
            PG8_WAIT_V(8); PG8_WAIT_L(0); PG8_BAR; PG8_MMA(0, 0, At, B0); PG8_MMA(0, 1, At, B1); PG8_BAR; PG8_SCHED;
            PG8_LDA(At, 0, 1); PG8_STAGE(PG8_SB(0, 0), b2, xB0, xB1); PG8_STAGE(PG8_SB(0, 1), b2 + xhB, xB0, xB1); PG8_STAGE(PG8_SA(0, 0), a2, xA0, xA1);
            PG8_WAIT_V(8); PG8_WAIT_L(0); PG8_BAR; PG8_MMA(1, 0, At, B0); PG8_MMA(1, 1, At, B1); PG8_BAR; PG8_SCHED;
            PG8_LDB(B0, 1, 0); PG8_LDB(B1, 1, 1); PG8_SCHED; PG8_LDA(At, 1, 0); PG8_STAGE(PG8_SA(0, 1), a2 + xhA, xA0, xA1);
            PG8_WAIT_V(8); PG8_WAIT_L(0); PG8_BAR; PG8_MMA(0, 0, At, B0); PG8_MMA(0, 1, At, B1); PG8_BAR; PG8_SCHED;
            PG8_LDA(At, 1, 1); PG8_STAGE(PG8_SB(1, 0), b3, xB0, xB1); PG8_STAGE(PG8_SB(1, 1), b3 + xhB, xB0, xB1); PG8_STAGE(PG8_SA(1, 0), a3, xA0, xA1);
            PG8_WAIT_V(8); PG8_WAIT_L(0); PG8_BAR; PG8_MMA(1, 0, At, B0); PG8_MMA(1, 1, At, B1); PG8_BAR; PG8_SCHED;
        }
        if (wr == 0) PG8_BAR;
        const float pre_nxt = has_next ? E.pre(nxt, tid) : 0.f;
        E(acc, cur, wr, wc, fr, fq, tid, pre_cur);
        if (!has_next) break;
        pre_cur = pre_nxt;
#pragma unroll
        for (int a = 0; a < 2; ++a)
#pragma unroll
            for (int b = 0; b < 2; ++b)
#pragma unroll
                for (int m = 0; m < 4; ++m)
#pragma unroll
                    for (int n = 0; n < 2; ++n) acc[a][b][m][n] = (f32x4){0.f, 0.f, 0.f, 0.f};
        cur = nxt; cA = nA; cB = nB; ++ui;
        if (wr == 1) PG8_BAR;
    }
    PG8_WAIT_V(0);
    PG8_BAR;
#undef PG8_SA
#undef PG8_SB
#undef PG8_STAGE
#undef PG8_LDA
#undef PG8_LDB
#undef PG8_MMA
#undef PG8_WAIT_V
#undef PG8_WAIT_L
#undef PG8_BAR
#undef PG8_SCHED
}

__device__ __forceinline__ void tile_of(int wgid, int nM, int nN, int& pm, int& pn) {
    const int nwg = nM * nN;
    { const int q = nwg / 8, r = nwg % 8, xcd = wgid % 8, off = wgid / 8; wgid = (xcd < r ? xcd * (q + 1) : r * (q + 1) + (xcd - r) * q) + off; }
    const int nig = 8 * nN, gid = wgid / nig, fm = gid * 8, gsz = (nM - fm) < 8 ? (nM - fm) : 8;
    pm = fm + ((wgid % nig) % gsz); pn = (wgid % nig) / gsz;
}
}

template <int KSET>
struct Epi {
    unsigned char* ws; const float* xin; float* xout; int layer; LAS unsigned char* lds_misc;
    __device__ __forceinline__ float row_rstd(int row) const {
        const f32x4* p = (const f32x4*)(ws + WS_SS) + (size_t)row * 4;
        const f32x4 a = p[0], b = p[1], c = p[2], d = p[3];
        const float s = ((a[0] + a[1]) + (a[2] + a[3])) + ((b[0] + b[1]) + (b[2] + b[3])) + ((c[0] + c[1]) + (c[2] + c[3])) + ((d[0] + d[1]) + (d[2] + d[3]));
        return __builtin_amdgcn_rsqf(s * (1.0f / DM) + RMS_EPS);
    }
    template <int SUB>
    __device__ __forceinline__ void inproj_tile(const f32x4 (&acc)[2][2][4][2], f16* dst, int ld, int rbase, int cl0, int wr, int fr, LAS float* rtab, float* kmdst = nullptr) const {
        const f32x2* rope = (const f32x2*)(ws + WS_ROPE);
        f32x4 cs[2][2];
#pragma unroll
        for (int bj = 0; bj < 2; ++bj) { cs[bj][0] = (f32x4){0.f, 0.f, 0.f, 0.f}; cs[bj][1] = (f32x4){0.f, 0.f, 0.f, 0.f}; }
#pragma unroll
        for (int ai = 0; ai < 2; ++ai)
#pragma unroll
            for (int m = 0; m < 4; ++m) {
                const int row = rbase + ai * 128 + m * 16;
                const float rs = rtab[ai * 128 + wr * 64 + m * 16 + fr];
                const int pos = row & (SEQ - 1);
#pragma unroll
                for (int bj = 0; bj < 2; ++bj) {
                    f32x4 v0 = acc[ai][bj][m][0] * rs, v1 = acc[ai][bj][m][1] * rs;
                    const int cl = cl0 + bj * 128;
                    if (SUB == 7 && cl >= 64) {
                        if (cl == 64) { const float s8 = 0.35355339059327373f; f32x4* d = (f32x4*)((float*)(ws + WS_WI) + (size_t)row * 8); d[0] = v0 * s8; d[1] = v1 * s8; }
                        continue;
                    }
                    if (SUB == 0 || SUB == 1 || SUB == 4 || SUB == 7) {
                        if ((cl & 63) < 16) {
                            const f32x2* rp = rope + (size_t)pos * 8 + ((cl & 63) >> 1);
                            const f32x2 r0 = rp[0], r1 = rp[1], r2 = rp[2], r3 = rp[3];
                            f32x4 w0, w1;
                            w0[0] = v0[0] * r0[0] - v0[1] * r0[1]; w0[1] = v0[1] * r0[0] + v0[0] * r0[1];
                            w0[2] = v0[2] * r1[0] - v0[3] * r1[1]; w0[3] = v0[3] * r1[0] + v0[2] * r1[1];
                            w1[0] = v1[0] * r2[0] - v1[1] * r2[1]; w1[1] = v1[1] * r2[0] + v1[0] * r2[1];
                            w1[2] = v1[2] * r3[0] - v1[3] * r3[1]; w1[3] = v1[3] * r3[0] + v1[2] * r3[1];
                            v0 = w0; v1 = w1;
                        }
                    }
                    if (SUB == 1) { cs[bj][0] += v0; cs[bj][1] += v1; }
                    if (SUB == 0) { v0 = v0 * C2_64; v1 = v1 * C2_64; }
                    if (SUB == 4) { v0 = v0 * 0.125f; v1 = v1 * 0.125f; }
                    if (SUB == 5) { v0 = v0 * C2_128; v1 = v1 * C2_128; }
                    if (SUB == 3) {
#pragma unroll
                        for (int j = 0; j < 4; ++j) { v0[j] = silu_f(v0[j]); v1[j] = silu_f(v1[j]); }
                    }
                    u32x4 w; w.x = pk_f16(v0[0], v0[1]); w.y = pk_f16(v0[2], v0[3]); w.z = pk_f16(v1[0], v1[1]); w.w = pk_f16(v1[2], v1[3]);
                    *(u32x4*)(dst + (size_t)row * ld + cl) = w;
                }
            }
        if (SUB == 1) {
            if (kmdst) {
                LAS float* red = rtab + 256;
                const int wcq = (cl0 >> 3);
#pragma unroll
                for (int bj = 0; bj < 2; ++bj)
#pragma unroll
                    for (int n = 0; n < 2; ++n)
#pragma unroll
                        for (int j = 0; j < 4; ++j) { float v = cs[bj][n][j]; v += xor_lane<1>(v); v += xor_lane<2>(v); v += xor_lane<4>(v); v += xor_lane<8>(v);
                            if (fr == 0) red[wr * 256 + bj * 128 + wcq * 8 + n * 4 + j] = v; }
                asm volatile("s_waitcnt lgkmcnt(0)" ::: "memory"); __builtin_amdgcn_s_barrier(); asm volatile("" ::: "memory");
                if (wr == 0 && fr == 0) {
#pragma unroll
                    for (int bj = 0; bj < 2; ++bj)
#pragma unroll
                        for (int k = 0; k < 8; ++k) { const int i = bj * 128 + wcq * 8 + k; kmdst[i] = (red[i] + red[256 + i]) * (1.0f / 256.0f); }
                }
            }
        }
    }
    __device__ __forceinline__ float pre(const pg8::Unit& u, int tid) const {
        if ((KSET == 2 || (KSET == 0 && u.kind == pg8::K_INPROJ)) && tid < 256) return row_rstd(u.pm * 256 + tid);
        return 0.f;
    }
    __device__ __forceinline__ void operator()(const f32x4 (&acc)[2][2][4][2], const pg8::Unit& u, int wr, int wc, int fr, int fq, int tid, float pre) const {
        LAS float* rtab = (LAS float*)lds_misc;
        if (KSET == 2 || (KSET == 0 && u.kind == pg8::K_INPROJ)) {
            if (tid < 256) rtab[tid] = pre;
            asm volatile("s_waitcnt lgkmcnt(0)" ::: "memory"); __builtin_amdgcn_s_barrier(); asm volatile("" ::: "memory");
        } else if (KSET == 0) { __builtin_amdgcn_s_barrier(); }
        const int kind = (KSET == 0) ? u.kind : (KSET == 1) ? pg8::K_UP : (KSET == 2) ? pg8::K_MIX : pg8::K_OUT;
        const int rbase = u.pm * 256 + wr * 64 + fr;
        const int cl0 = wc * 32 + 8 * fq;
        if (KSET == 0 && kind == pg8::K_INPROJ) {
            const int pn = u.pn;
            if (pn < 16) { const int seg = pn >> 1, st = seg & 3;
                if (st == 0) inproj_tile<0>(acc, (f16*)(ws + (seg < 4 ? WS_QA : WS_QB)) + (pn & 1) * 256, 512, rbase, cl0, wr, fr, rtab);
                else if (st == 1) inproj_tile<1>(acc, (f16*)(ws + (seg < 4 ? WS_KA : WS_KB)) + (pn & 1) * 256, 512, rbase, cl0, wr, fr, rtab,
                                                 seg < 4 ? (float*)(ws + WS_KMEAN) + (size_t)u.pm * 512 + (pn & 1) * 256 : nullptr);
                else if (st == 2) inproj_tile<2>(acc, (f16*)(ws + (seg < 4 ? WS_VA : WS_VB)) + (pn & 1) * 256, 512, rbase, cl0, wr, fr, rtab);
                else inproj_tile<3>(acc, (f16*)(ws + WS_G) + (seg >> 2) * 512 + (pn & 1) * 256, 1536, rbase, cl0, wr, fr, rtab);
            } else if (pn < 18) inproj_tile<4>(acc, (f16*)(ws + WS_QI) + (pn & 1) * 256, 512, rbase, cl0, wr, fr, rtab);
            else if (pn < 20) inproj_tile<5>(acc, (f16*)(ws + WS_QM) + (pn & 1) * 256, 512, rbase, cl0, wr, fr, rtab);
            else if (pn < 22) inproj_tile<3>(acc, (f16*)(ws + WS_G) + 1024 + (pn & 1) * 256, 1536, rbase, cl0, wr, fr, rtab);
            else inproj_tile<7>(acc, (f16*)(ws + WS_KI), 64, rbase, cl0, wr, fr, rtab);
        } else if (KSET == 0) {
            f16* dstb = (f16*)(ws + WS_KVM) + (size_t)u.aux * 512 * 1024;
#pragma unroll
            for (int ai = 0; ai < 2; ++ai)
#pragma unroll
                for (int m = 0; m < 4; ++m) {
                    const int row = rbase + ai * 128 + m * 16;
#pragma unroll
                    for (int bj = 0; bj < 2; ++bj) {
                        const f32x4 v0 = acc[ai][bj][m][0], v1 = acc[ai][bj][m][1];
                        u32x4 w; w.x = pk_f16(v0[0], v0[1]); w.y = pk_f16(v0[2], v0[3]); w.z = pk_f16(v1[0], v1[1]); w.w = pk_f16(v1[2], v1[3]);
                        *(u32x4*)(dstb + (size_t)row * 1024 + u.pn * 256 + cl0 + bj * 128) = w;
                    }
                }
        } else if (KSET == 1) {
            f16* dstb = (f16*)(ws + WS_GU);
#pragma unroll
            for (int ai = 0; ai < 2; ++ai)
#pragma unroll
                for (int m = 0; m < 4; ++m) {
                    const int row = rbase + ai * 128 + m * 16;
#pragma unroll
                    for (int bj = 0; bj < 2; ++bj) {
                        const f32x4 v0 = acc[ai][bj][m][0], v1 = acc[ai][bj][m][1];
                        u32x4 w; w.x = pk_f16(v0[0], v0[1]); w.y = pk_f16(v0[2], v0[3]); w.z = pk_f16(v1[0], v1[1]); w.w = pk_f16(v1[2], v1[3]);
                        *(u32x4*)(dstb + (size_t)row * 3072 + u.aux * 1024 + u.pn * 256 + cl0 + bj * 128) = w;
                    }
                }
        } else if (KSET == 2) {
            const f16* ub = (const f16*)(ws + WS_GU); f16* mg = (f16*)(ws + WS_MG);
            const bool addp = (u.aux != 0);
#pragma unroll
            for (int ai = 0; ai < 2; ++ai) {
                f16x8 uo[4][2], pv[4][2];
#pragma unroll
                for (int m = 0; m < 4; ++m)
#pragma unroll
                    for (int bj = 0; bj < 2; ++bj) uo[m][bj] = *(const f16x8*)(ub + (size_t)(rbase + ai * 128 + m * 16) * 3072 + u.aux * 1024 + u.pn * 256 + cl0 + bj * 128);
                if (addp) {
#pragma unroll
                    for (int m = 0; m < 4; ++m)
#pragma unroll
                        for (int bj = 0; bj < 2; ++bj) pv[m][bj] = *(const f16x8*)(mg + (size_t)(rbase + ai * 128 + m * 16) * 1024 + u.pn * 256 + cl0 + bj * 128);
                } else {
#pragma unroll
                    for (int m = 0; m < 4; ++m)
#pragma unroll
                        for (int bj = 0; bj < 2; ++bj) pv[m][bj] = (f16x8){0, 0, 0, 0, 0, 0, 0, 0};
                }
#pragma unroll
                for (int m = 0; m < 4; ++m) {
                    const int row = rbase + ai * 128 + m * 16;
                    const float rs = rtab[ai * 128 + wr * 64 + m * 16 + fr];
#pragma unroll
                    for (int bj = 0; bj < 2; ++bj) {
                        const int col = u.pn * 256 + cl0 + bj * 128;
                        const f32x4 a0 = acc[ai][bj][m][0] * rs, a1 = acc[ai][bj][m][1] * rs;
                        f32x4 v0, v1;
#pragma unroll
                        for (int j = 0; j < 4; ++j) { v0[j] = sigmoid_f(a0[j]) * (float)uo[m][bj][j] + (float)pv[m][bj][j]; v1[j] = sigmoid_f(a1[j]) * (float)uo[m][bj][4 + j] + (float)pv[m][bj][4 + j]; }
                        u32x4 w; w.x = pk_f16(v0[0], v0[1]); w.y = pk_f16(v0[2], v0[3]); w.z = pk_f16(v1[0], v1[1]); w.w = pk_f16(v1[2], v1[3]);
                        *(u32x4*)(mg + (size_t)row * 1024 + col) = w;
                    }
                }
            }
        } else {
            f16* xh = (f16*)(ws + WS_XH); float* ss = (float*)(ws + WS_SS);
#pragma unroll
            for (int ai = 0; ai < 2; ++ai) {
                f16x8 xb[4][2];
#pragma unroll
                for (int m = 0; m < 4; ++m)
#pragma unroll
                    for (int bj = 0; bj < 2; ++bj) xb[m][bj] = *(const f16x8*)(xh + (size_t)(rbase + ai * 128 + m * 16) * DM + u.pn * 256 + cl0 + bj * 128);
#pragma unroll
                for (int m = 0; m < 4; ++m) {
                    const int row = rbase + ai * 128 + m * 16;
                    float sq = 0.f;
#pragma unroll
                    for (int bj = 0; bj < 2; ++bj) {
                        const size_t off = (size_t)row * DM + u.pn * 256 + cl0 + bj * 128;
                        const f32x4 b0 = {(float)xb[m][bj][0], (float)xb[m][bj][1], (float)xb[m][bj][2], (float)xb[m][bj][3]}, b1 = {(float)xb[m][bj][4], (float)xb[m][bj][5], (float)xb[m][bj][6], (float)xb[m][bj][7]};
                        const f32x4 v0 = b0 + acc[ai][bj][m][0], v1 = b1 + acc[ai][bj][m][1];
                        u32x4 w; w.x = pk_f16(v0[0], v0[1]); w.y = pk_f16(v0[2], v0[3]); w.z = pk_f16(v1[0], v1[1]); w.w = pk_f16(v1[2], v1[3]);
                        *(u32x4*)(xh + off) = w;
                        sq += (v0[0] * v0[0] + v0[1] * v0[1]) + (v0[2] * v0[2] + v0[3] * v0[3]) + (v1[0] * v1[0] + v1[1] * v1[1]) + (v1[2] * v1[2] + v1[3] * v1[3]);
                    }
                    sq += xor_lane<16>(sq); { auto rr = __builtin_amdgcn_permlane32_swap(__float_as_uint(sq), __float_as_uint(sq), false, false); sq = __uint_as_float(rr[0]) + __uint_as_float(rr[1]); }
                    if (fq == 0) ss[(size_t)row * 16 + u.pn * 4 + wc] = sq;
                }
            }
        }
    }
};

struct SchedInproj {
    unsigned char* ws; int layer, G, c;
    __device__ __forceinline__ bool next(int i, pg8::Unit& u) const {
        const int L = i * G + c; const int n1 = 64 * 23;
        if (L < n1) { int pm, pn; pg8::tile_of(L, 64, 23, pm, pn);
            u.A = (const char*)(ws + WS_XH) + (size_t)pm * 256 * 2048; u.B = (const char*)(ws + WS_WIN) + ((size_t)layer * NPHYS + (size_t)pn * 256) * 2048;
            u.kind = pg8::K_INPROJ; u.pm = pm; u.pn = pn; u.aux = layer; return true; }
        if (layer != 0) return false;
        const int r = L - n1; if (r >= 32) return false;
        const int l = r >> 3, pm = (r >> 2) & 1, pn = r & 3;
        u.A = (const char*)(ws + WS_MEMN) + (size_t)pm * 256 * 2048; u.B = (const char*)(ws + WS_WMKV) + ((size_t)l * 1024 + (size_t)pn * 256) * 2048;
        u.kind = pg8::K_MEMKV; u.pm = pm; u.pn = pn; u.aux = l; return true;
    }
};
struct SchedUp {
    unsigned char* ws; int layer, G, c;
    __device__ __forceinline__ bool next(int i, pg8::Unit& u) const {
        const int T = (i / 3) * G + c, br = i % 3; if (T >= 64 * 4) return false;
        int pm, pn; pg8::tile_of(T, 64, 4, pm, pn);
        u.A = (const char*)(ws + WS_Y) + ((size_t)pm * 256 * 1536 + br * 512) * 2; u.B = (const char*)(ws + WS_WBR) + (((size_t)layer * 3 + br) * 1024 + (size_t)pn * 256) * 1024;
        u.kind = pg8::K_UP; u.pm = pm; u.pn = pn; u.aux = br; return true;
    }
};
struct SchedMix {
    unsigned char* ws; int layer, G, c;
    __device__ __forceinline__ bool next(int i, pg8::Unit& u) const {
        const int T = (i / 3) * G + c, br = i % 3; if (T >= 64 * 4) return false;
        int pm, pn; pg8::tile_of(T, 64, 4, pm, pn);
        u.A = (const char*)(ws + WS_XH) + (size_t)pm * 256 * 2048; u.B = (const char*)(ws + WS_WMIX) + ((size_t)layer * 3072 + br * 1024 + (size_t)pn * 256) * 2048;
        u.kind = pg8::K_MIX; u.pm = pm; u.pn = pn; u.aux = br; return true;
    }
};
struct SchedOut {
    unsigned char* ws; int layer, G, c;
    __device__ __forceinline__ bool next(int i, pg8::Unit& u) const {
        const int L = i * G + c; if (L >= 256) return false;
        int pm, pn; pg8::tile_of(L, 64, 4, pm, pn);
        u.A = (const char*)(ws + WS_MG) + (size_t)pm * 256 * 2048; u.B = (const char*)(ws + WS_WOUT) + ((size_t)layer * 1024 + (size_t)pn * 256) * 6144;
        u.kind = pg8::K_OUT; u.pm = pm; u.pn = pn; u.aux = layer; return true;
    }
};

template <class ColMap>
__device__ __forceinline__ void convert_w(const float* src, int sld, const float* scale, f16* dst, int N, int K, int dld, int dcol, ColMap cm, LAS float* scr, int lane, int gw, int ngw) {
    const int nblk = N / 32, items = (K / 64) * nblk;
    for (int it = gw; it < items; it += ngw) {
        const int kb = it / nblk, nb = it - kb * nblk, k0 = 64 * kb, n0 = 32 * nb;
        const int col = cm(n0 + (lane & 31));
        float tv[32];
#pragma unroll
        for (int i = 0; i < 32; ++i) { const int kk = 2 * i + (lane >> 5); tv[i] = (col >= 0) ? src[(size_t)(k0 + kk) * sld + col] : 0.f; }
#pragma unroll
        for (int i = 0; i < 32; ++i) { const int kk = 2 * i + (lane >> 5); const float sc = scale ? scale[k0 + kk] : 1.0f; scr[kk * 33 + (lane & 31)] = tv[i] * sc; }
        asm volatile("s_waitcnt lgkmcnt(0)" ::: "memory");
        const int c = lane & 7;
#pragma unroll
        for (int j = 0; j < 4; ++j) { const int n = (lane >> 3) + 8 * j; const LAS float* sp = scr + (8 * c) * 33 + n;
            u32x4 w; w.x = pk_f16(sp[0 * 33], sp[1 * 33]); w.y = pk_f16(sp[2 * 33], sp[3 * 33]); w.z = pk_f16(sp[4 * 33], sp[5 * 33]); w.w = pk_f16(sp[6 * 33], sp[7 * 33]);
            *(u32x4*)(dst + (size_t)(n0 + n) * dld + dcol + k0 + 8 * c) = w; }
        asm volatile("s_waitcnt lgkmcnt(0)" ::: "memory");
    }
}
struct MapIn { __device__ __forceinline__ int operator()(int n) const {
    if (n < 4096) { const int seg = n >> 9, st = seg & 3, p = n & 63; return (st < 2) ? (n - p + unperm64(p)) : n; }
    if (n < 4608) { const int p = n & 63; return L_IQ + (n - 4096) - p + unperm64(p); }
    if (n < 5120) return L_MQ + (n - 4608);
    if (n < 5632) return L_MG + (n - 5120);
    if (n < 5696) return L_IK + unperm64(n - 5632);
    if (n < 5704) return L_IW + (n - 5696);
    return -1; } };
struct MapOff { int off; __device__ __forceinline__ int operator()(int n) const { return off + n; } };

__device__ __forceinline__ void phase_prologue(const Params& P, LAS unsigned char* lds) {
    unsigned char* ws = opaque_ptr(P.ws);
    const int gtid = o_blk() * 512 + opaque_tid(), gthreads = o_grid() * 512;
    const int lane = gtid & 63, gw = gtid >> 6, ngw = gthreads >> 6;
    LAS float* scr = (LAS float*)lds + ((gtid >> 6) & 7) * (64 * 33);
    for (int l = 0; l < DEPTH; ++l) {
        convert_w(P.w_in + (size_t)l * DM * INC, INC, P.norm_g + l * DM, (f16*)(ws + WS_WIN) + (size_t)l * NPHYS * DM, NPHYS, DM, DM, 0, MapIn{}, scr, lane, gw, ngw);
        convert_w(P.w_in + (size_t)l * DM * INC, INC, P.norm_g + l * DM, (f16*)(ws + WS_WMIX) + (size_t)l * 3072 * DM, 3072, DM, DM, 0, MapOff{L_MIX}, scr, lane, gw, ngw);
        convert_w(P.w_mem_kv + (size_t)l * DM * 1024, 1024, P.mem_norm_g + l * DM, (f16*)(ws + WS_WMKV) + (size_t)l * 1024 * DM, 1024, DM, DM, 0, MapOff{0}, scr, lane, gw, ngw);
        for (int n = 0; n < 3; ++n)
            convert_w(P.w_branch + ((size_t)l * 3 + n) * 512 * DM, DM, nullptr, (f16*)(ws + WS_WBR) + ((size_t)l * 3 + n) * 1024 * 512, 1024, 512, 512, 0, MapOff{0}, scr, lane, gw, ngw);
        convert_w(P.w_out + (size_t)l * DM * DM, DM, nullptr, (f16*)(ws + WS_WOUT) + (size_t)l * 1024 * 3072, 1024, DM, 3072, 0, MapOff{0}, scr, lane, gw, ngw);
    }
    for (int r = gw; r < M; r += ngw) {
        const f32x4* xr = (const f32x4*)(P.x + (size_t)r * DM) + lane; float s = 0.f;
        u32x2* o = (u32x2*)((f16*)(ws + WS_XH) + (size_t)r * DM) + lane;
#pragma unroll
        for (int j = 0; j < 4; ++j) { const f32x4 v = xr[64 * j]; s += (v[0] * v[0] + v[1] * v[1]) + (v[2] * v[2] + v[3] * v[3]); u32x2 w; w.x = pk_f16(v[0], v[1]); w.y = pk_f16(v[2], v[3]); o[64 * j] = w; }
        s = wave_sum(s);
        if (lane < 16) ((float*)(ws + WS_SS))[(size_t)r * 16 + lane] = (lane == 0) ? s : 0.f;
    }
    for (int r = gw; r < BATCH * NMEM; r += ngw) {
        const f32x4* xr = (const f32x4*)(P.mem + (size_t)r * DM) + lane; float s = 0.f; f32x4 v[4];
#pragma unroll
        for (int j = 0; j < 4; ++j) { v[j] = xr[64 * j]; s += (v[j][0] * v[j][0] + v[j][1] * v[j][1]) + (v[j][2] * v[j][2] + v[j][3] * v[j][3]); }
        const float rs = __builtin_amdgcn_rsqf(wave_sum(s) * (1.0f / DM) + RMS_EPS);
        u32x2* o = (u32x2*)((f16*)(ws + WS_MEMN) + (size_t)r * DM) + lane;
#pragma unroll
        for (int j = 0; j < 4; ++j) { u32x2 w; w.x = pk_f16(v[j][0] * rs, v[j][1] * rs); w.y = pk_f16(v[j][2] * rs, v[j][3] * rs); o[64 * j] = w; }
    }
    for (int it = gtid; it < SEQ * 8; it += gthreads) {
        const int pos = it >> 3, i = it & 7;
        const float inv = powf(500000.0f, -(float)i / 8.0f);
        const float ang = (float)pos * inv;
        float sn, cs; sincosf(ang, &sn, &cs);
        ((f32x2*)(ws + WS_ROPE))[it] = (f32x2){cs, sn};
    }
}


__device__ __forceinline__ void phase_memattn(const Params& P, int layer, LAS unsigned char* lds) {
    typedef float f32x16 __attribute__((ext_vector_type(16)));
    typedef short s16x4 __attribute__((ext_vector_type(4)));
    typedef short s16x8 __attribute__((ext_vector_type(8)));
    unsigned char* ws = opaque_ptr(P.ws);
    const int tid = opaque_tid(), lane = tid & 63, wid = tid >> 6, r32 = lane & 31, hi = lane >> 5;
    const f16* QM = (const f16*)(ws + WS_QM); const f16* KV = (const f16*)(ws + WS_KVM) + (size_t)layer * 512 * 1024;
    const f16* G = (const f16*)(ws + WS_G); f16* Y = (f16*)(ws + WS_Y);
    LAS unsigned char* kl = lds;
    LAS unsigned char* vl = lds + 65536;
    LAS float* wsf = (LAS float*)(lds + 131072) + wid * 64;
    const int G_ = o_grid();
    for (int u = o_blk(); u < 256; u += G_) {
        const int qb = u & 31, bh = u >> 5, b = bh >> 2, h = bh & 3;
        __syncthreads();
#pragma unroll
        for (int i = 0; i < 8; ++i) { const int p = tid + 512 * i;
            { const int row = p & 255, chunk = p >> 8; *(LAS u32x4*)(kl + chunk * 4096 + row * 16) = *(const u32x4*)(KV + (size_t)(b * 256 + row) * 1024 + h * 128 + chunk * 8); }
            { const int d0 = p >> 10, kv = (p >> 2) & 255, pc = p & 3; *(LAS u32x4*)(vl + p * 16) = *(const u32x4*)(KV + (size_t)(b * 256 + kv) * 1024 + 512 + h * 128 + d0 * 32 + pc * 8); } }
        const size_t row0 = (size_t)b * SEQ + qb * 256 + wid * 32;
        f16x8 qr[8];
#pragma unroll
        for (int ks = 0; ks < 8; ++ks) qr[ks] = *(const f16x8*)(QM + (row0 + r32) * 512 + h * 128 + 16 * ks + 8 * hi);
        __syncthreads();
        f32x16 sc[8];
#pragma unroll
        for (int kg = 0; kg < 8; ++kg) { f32x16 a;
#pragma unroll
            for (int ks = 0; ks < 8; ++ks) { const f16x8 kf = *(const LAS f16x8*)(kl + (2 * ks + hi) * 4096 + (32 * kg + r32) * 16);
                a = (ks == 0) ? __builtin_amdgcn_mfma_f32_32x32x16_f16(kf, qr[ks], (f32x16){0.f, 0.f, 0.f, 0.f, 0.f, 0.f, 0.f, 0.f, 0.f, 0.f, 0.f, 0.f, 0.f, 0.f, 0.f, 0.f}, 0, 0, 0)
                              : __builtin_amdgcn_mfma_f32_32x32x16_f16(kf, qr[ks], a, 0, 0, 0); }
            sc[kg] = a; __builtin_amdgcn_sched_barrier(0); }
        float mx = sc[0][0];
#pragma unroll
        for (int kg = 0; kg < 8; ++kg)
#pragma unroll
            for (int r = 0; r < 16; ++r) mx = fmaxf(mx, sc[kg][r]);
        { auto rr = __builtin_amdgcn_permlane32_swap(__float_as_uint(mx), __float_as_uint(mx), false, false); mx = fmaxf(__uint_as_float(rr[0]), __uint_as_float(rr[1])); }
        float l = 0.f; u32x4 pw[8][2];
#pragma unroll
        for (int kg = 0; kg < 8; ++kg) {
#pragma unroll
            for (int r = 0; r < 16; ++r) { const float p = __builtin_amdgcn_exp2f(sc[kg][r] - mx); sc[kg][r] = p; l += p; }
#pragma unroll
            for (int s2 = 0; s2 < 2; ++s2) { pw[kg][s2].x = pk_f16(sc[kg][8 * s2 + 0], sc[kg][8 * s2 + 1]); pw[kg][s2].y = pk_f16(sc[kg][8 * s2 + 2], sc[kg][8 * s2 + 3]);
                                            pw[kg][s2].z = pk_f16(sc[kg][8 * s2 + 4], sc[kg][8 * s2 + 5]); pw[kg][s2].w = pk_f16(sc[kg][8 * s2 + 6], sc[kg][8 * s2 + 7]); }
            __builtin_amdgcn_sched_barrier(0);
        }
        { auto rr = __builtin_amdgcn_permlane32_swap(__float_as_uint(l), __float_as_uint(l), false, false); l = __uint_as_float(rr[0]) + __uint_as_float(rr[1]); }
        f32x16 o[4];
#pragma unroll
        for (int d0 = 0; d0 < 4; ++d0) o[d0] = (f32x16){0.f, 0.f, 0.f, 0.f, 0.f, 0.f, 0.f, 0.f, 0.f, 0.f, 0.f, 0.f, 0.f, 0.f, 0.f, 0.f};
        const LAS unsigned char* vb = vl + (4 * hi + ((lane & 15) >> 2)) * 64 + ((lane >> 4) & 1) * 32 + (lane & 3) * 8;
#pragma unroll
        for (int kg = 0; kg < 8; ++kg)
#pragma unroll
            for (int s2 = 0; s2 < 2; ++s2) {
                const f16x8 pa = __builtin_bit_cast(f16x8, pw[kg][s2]);
#pragma unroll
                for (int d0 = 0; d0 < 4; ++d0) {
                    const LAS unsigned char* va = vb + d0 * 16384 + (32 * kg + 16 * s2) * 64;
                    const s16x4 lo = __builtin_bit_cast(s16x4, __builtin_amdgcn_ds_read_tr16_b64_v4i16((LAS s16x4*)va));
                    const s16x4 hh = __builtin_bit_cast(s16x4, __builtin_amdgcn_ds_read_tr16_b64_v4i16((LAS s16x4*)(va + 512)));
                    const s16x8 vv = {lo[0], lo[1], lo[2], lo[3], hh[0], hh[1], hh[2], hh[3]};
                    o[d0] = __builtin_amdgcn_mfma_f32_32x32x16_f16(pa, __builtin_bit_cast(f16x8, vv), o[d0], 0, 0, 0);
                }
                __builtin_amdgcn_sched_barrier(0);
            }
        if (hi == 0) wsf[r32] = l;
        __syncthreads();
        float rli[16];
#pragma unroll
        for (int r = 0; r < 16; ++r) rli[r] = __builtin_amdgcn_rcpf(wsf[(r & 3) + 8 * (r >> 2) + 4 * hi]);
        LAS f16* stg = (LAS f16*)(kl + wid * 8192);
#pragma unroll
        for (int r = 0; r < 16; ++r) { const int orow = (r & 3) + 8 * (r >> 2) + 4 * hi;
#pragma unroll
            for (int d0 = 0; d0 < 4; ++d0) stg[orow * 128 + d0 * 32 + r32] = (f16)(o[d0][r] * rli[r]); }
        asm volatile("s_waitcnt lgkmcnt(0)" ::: "memory");
#pragma unroll
        for (int i = 0; i < 8; ++i) { const int pc = lane + 64 * i, row = pc >> 4, ch = pc & 15;
            const f16x8 ov = *(const LAS f16x8*)(stg + row * 128 + ch * 8);
            const size_t go = (row0 + row) * 1536 + 1024 + h * 128 + ch * 8;
            const f16x8 gv = *(const f16x8*)(G + go);
            u32x4 w; w.x = pk_f16((float)ov[0] * (float)gv[0], (float)ov[1] * (float)gv[1]); w.y = pk_f16((float)ov[2] * (float)gv[2], (float)ov[3] * (float)gv[3]);
            w.z = pk_f16((float)ov[4] * (float)gv[4], (float)ov[5] * (float)gv[5]); w.w = pk_f16((float)ov[6] * (float)gv[6], (float)ov[7] * (float)gv[7]);
            *(u32x4*)(Y + go) = w; }
    }
}

#ifndef IDX_SETUP
#define IDX_SETUP 2
#endif
__device__ __forceinline__ float relu_bits(float x) { const int b = __builtin_bit_cast(int, x); return __builtin_bit_cast(float, b > 0 ? b : 0); }
__device__ __forceinline__ void phase_index(const Params& P, int chunk, LAS unsigned char* lds) {
    typedef float f32x16 __attribute__((ext_vector_type(16)));
    unsigned char* ws = opaque_ptr(P.ws); const int tid = opaque_tid(), lane = tid & 63, wid = tid >> 6, n = lane & 31, kh = lane >> 5;
    const f16* QI = (const f16*)(ws + WS_QI); const f16* KI = (const f16*)(ws + WS_KI); const float* WI = (const float*)(ws + WS_WI); float* SC = (float*)(ws + WS_SC);
    const int ta = ch_t(chunk), tb = ch_t(chunk + 1), nrows = tb - ta, nqb = nrows >> 7;
    const int i0 = ta >> 7;
    const int Wb = (i0 + nqb) * (i0 + nqb + 1) - i0 * (i0 + 1) + IDX_SETUP * nqb, W = 2 * Wb;
    LAS float* wl = (LAS float*)lds;
    LAS unsigned char* kb = lds + 4096;
    LAS unsigned* tbuf = (LAS unsigned*)(lds + 40960) + (tid >> 6) * 576;
    const int G_ = o_grid(), c_ = o_blk();
    int Ls = (int)(((long)c_ * W) / G_); const int Le = (int)(((long)(c_ + 1) * W) / G_);
    while (Ls < Le) {
        const int b = Ls >= Wb ? 1 : 0; int v = Ls - b * Wb, qi = 0;
        for (;; ++qi) { const int ns = 2 * (i0 + qi + 1) + IDX_SETUP; if (v < ns) break; v -= ns; }
        int nv = 2 * (i0 + qi + 1) + IDX_SETUP - v; if (nv > Le - Ls) nv = Le - Ls;
        Ls += nv;
        int vs = v - IDX_SETUP, ve = v + nv - IDX_SETUP;
        if (vs < 0) vs = 0;
        if (ve <= vs) continue;
        v = vs;
        const int ntile = ve - vs;
        const int t0 = ta + 128 * qi, sb = v << 6;
        const int tw = t0 + 16 * wid;
        __syncthreads();
        if (tid < 256) { f32x4 w = *(const f32x4*)(WI + (size_t)(b * SEQ + t0) * 8 + tid * 4); w *= 0.125f; *(LAS f32x4*)(wl + tid * 4) = w; }
        f16x8 A[4][4];
        { const int a = n >> 3, hh = (n >> 2) & 1, c = n & 3, head = 4 * (a & 1) + c, tko = 2 * hh + (a >> 1);
#pragma unroll
          for (int g = 0; g < 4; ++g)
#pragma unroll
              for (int ks = 0; ks < 4; ++ks) A[g][ks] = *(const f16x8*)(QI + (size_t)(b * SEQ + tw + 4 * g + tko) * 512 + head * 64 + 16 * ks + 8 * kh); }
        const f16* kg = KI + (size_t)(b * SEQ + sb + (tid & 63)) * 64 + (tid >> 6) * 8;
        u32x4 st = *(const u32x4*)kg;
        *(LAS u32x4*)(kb + (tid >> 6) * 1024 + (tid & 63) * 16) = st;
        __syncthreads();
        const int rpitch = 64 * ((t0 >> 7) + 1);
        unsigned* srow = (unsigned*)SC + (size_t)b * SC_PB + sc_row(tw);
        for (int j = 0; j < ntile; ++j) {
            const bool more = (j + 1 < ntile);
            if (more) st = *(const u32x4*)(kg + (size_t)(j + 1) * 64 * 64);
            if (sb + 64 * j <= tw + 15)
            {
                const LAS unsigned char* kt = kb + (j & 1) * 8192 + kh * 1024 + n * 16;
                f16x8 B[2][4];
#pragma unroll
                for (int half = 0; half < 2; ++half)
#pragma unroll
                    for (int ks = 0; ks < 4; ++ks) B[half][ks] = *(const LAS f16x8*)(kt + ks * 2048 + half * 512);
#define IDX_Z16 (f32x16){0.f, 0.f, 0.f, 0.f, 0.f, 0.f, 0.f, 0.f, 0.f, 0.f, 0.f, 0.f, 0.f, 0.f, 0.f, 0.f}
#define IDX_MF(g, AC) { _Pragma("unroll") for (int half = 0; half < 2; ++half) { \
                        AC[half] = __builtin_amdgcn_mfma_f32_32x32x16_f16(A[g][0], B[half][0], IDX_Z16, 0, 0, 0); \
                        _Pragma("unroll") for (int ks = 1; ks < 4; ++ks) AC[half] = __builtin_amdgcn_mfma_f32_32x32x16_f16(A[g][ks], B[half][ks], AC[half], 0, 0, 0); } \
                      __builtin_amdgcn_sched_barrier(0); }
#define IDX_EP(g, AC) { const LAS f32x4* wp = (const LAS f32x4*)(wl + (16 * wid + 4 * (g) + 2 * kh) * 8); \
                      const f32x4 w0 = wp[0], w1 = wp[1], w2 = wp[2], w3 = wp[3]; float sv[2][2]; \
                      _Pragma("unroll") for (int half = 0; half < 2; ++half) { float s0 = 0.f, s1 = 0.f; \
                        _Pragma("unroll") for (int hh = 0; hh < 4; ++hh) { s0 = __builtin_fmaf(w0[hh], relu_bits(AC[half][hh]), s0); s1 = __builtin_fmaf(w2[hh], relu_bits(AC[half][8 + hh]), s1); } \
                        _Pragma("unroll") for (int hh = 0; hh < 4; ++hh) { s0 = __builtin_fmaf(w1[hh], relu_bits(AC[half][4 + hh]), s0); s1 = __builtin_fmaf(w3[hh], relu_bits(AC[half][12 + hh]), s1); } \
                        sv[half][0] = s0; sv[half][1] = s1; } \
                      tbuf[(4 * (g) + 2 * kh) * 36 + n] = __builtin_bit_cast(unsigned, __builtin_amdgcn_cvt_pknorm_i16(sv[0][0], sv[1][0])); \
                      tbuf[(4 * (g) + 2 * kh + 1) * 36 + n] = __builtin_bit_cast(unsigned, __builtin_amdgcn_cvt_pknorm_i16(sv[0][1], sv[1][1])); \
                      __builtin_amdgcn_sched_barrier(0); }
#define IDX_ST() if (more) *(LAS u32x4*)(kb + ((j + 1) & 1) * 8192 + (tid >> 6) * 1024 + (tid & 63) * 16) = st;
                f32x16 accA[2], accB[2];
                if (wid < 4) {
                    IDX_MF(0, accA) IDX_EP(0, accA) IDX_MF(1, accA) IDX_EP(1, accA) IDX_MF(2, accA) IDX_EP(2, accA) IDX_ST() IDX_MF(3, accA) IDX_EP(3, accA)
                } else {
                    IDX_MF(0, accA) IDX_MF(1, accB) IDX_EP(0, accA) IDX_MF(2, accA) IDX_EP(1, accB) IDX_MF(3, accB) IDX_ST() IDX_EP(2, accA) IDX_EP(3, accB)
                }
                {
                    unsigned* d = srow + (size_t)(lane >> 3) * rpitch + 32 * ((sb >> 6) + j) + 4 * (lane & 7);
                    const u32x4 r0 = *(const LAS u32x4*)(tbuf + (lane >> 3) * 36 + 4 * (lane & 7)), r1 = *(const LAS u32x4*)(tbuf + ((lane >> 3) + 8) * 36 + 4 * (lane & 7));
                    *(u32x4*)d = r0; *(u32x4*)(d + (size_t)8 * rpitch) = r1;
                }
            } else if (more) *(LAS u32x4*)(kb + ((j + 1) & 1) * 8192 + (tid >> 6) * 1024 + (tid & 63) * 16) = st;
            __syncthreads();
        }
    }
}

__device__ __forceinline__ unsigned sortable(float f) { const unsigned u = __builtin_bit_cast(unsigned, f); return (u & 0x80000000u) ? ~u : (u | 0x80000000u); }
template <int W> __device__ __forceinline__ void putw(unsigned& a0l, unsigned& a0h, unsigned& a1l, unsigned& a1h, unsigned lo, unsigned hi) {
    if (W < 64) { asm volatile("v_writelane_b32 %0, %1, %2" : "+v"(a0l) : "s"(lo), "n"(W & 63)); asm volatile("v_writelane_b32 %0, %1, %2" : "+v"(a0h) : "s"(hi), "n"(W & 63)); }
    else { asm volatile("v_writelane_b32 %0, %1, %2" : "+v"(a1l) : "s"(lo), "n"(W & 63)); asm volatile("v_writelane_b32 %0, %1, %2" : "+v"(a1h) : "s"(hi), "n"(W & 63)); }
}
template <int V> struct IntC { static constexpr int value = V; };
template <int J, int N, class F> __device__ __forceinline__ void static_for_pairs(F&& f) { if constexpr (J < N) { f(IntC<J>{}); static_for_pairs<J + 1, N>(f); } }
namespace att { __device__ __forceinline__ void glds16(const void* g, unsigned lds_base); }
template <int NP>
__device__ __forceinline__ void select_row(const LAS unsigned* rbuf, u64* brow, int t, int ln, LAS unsigned* hist, const unsigned* nsrc, unsigned nlds, int ndma) {
    int x[NP];
#pragma unroll
    for (int j = 0; j < NP; ++j) x[j] = (int)rbuf[j * 64 + ln];
    const int kofs = ln + (ln & 32);
#pragma unroll
    for (int j = NP - 8; j < NP; ++j) {
        const int lim = t - 128 * j;
        if (kofs > lim) x[j] = (x[j] & (int)0xFFFF0000) | 0x8000;
        if (kofs + 32 > lim) x[j] = (x[j] & 0xFFFF) | (int)0x80000000;
    }
    asm volatile("s_waitcnt lgkmcnt(0)" ::: "memory");
    for (int q = 0; q < ndma; ++q) att::glds16(nsrc + q * 256 + ln * 4, (unsigned)__builtin_amdgcn_readfirstlane(nlds + q * 1024));
    int tauq = 0, nge = 0; bool exact = false;
    {
        auto scan_find = [&](int want, int& bin, int& above) {
            const u32x4 hv = *(const LAS u32x4*)(hist + (252 - 4 * ln));
            const unsigned tot = (hv.x + hv.y) + (hv.z + hv.w);
            unsigned p = tot;
            p += (unsigned)__builtin_amdgcn_update_dpp(0, (int)p, 0x111, 0xf, 0xf, false); p += (unsigned)__builtin_amdgcn_update_dpp(0, (int)p, 0x112, 0xf, 0xf, false);
            p += (unsigned)__builtin_amdgcn_update_dpp(0, (int)p, 0x114, 0xf, 0xf, false); p += (unsigned)__builtin_amdgcn_update_dpp(0, (int)p, 0x118, 0xf, 0xf, false);
            p += (unsigned)__builtin_amdgcn_update_dpp(0, (int)p, 0x142, 0xa, 0xf, false); p += (unsigned)__builtin_amdgcn_update_dpp(0, (int)p, 0x143, 0xc, 0xf, false);
            const u64 m = __ballot((int)p >= want);
            const int L = __builtin_ctzll(m);
            const int pl = __builtin_amdgcn_readlane((int)p, L), tl = __builtin_amdgcn_readlane((int)tot, L);
            const int h3 = __builtin_amdgcn_readlane((int)hv.w, L), h2 = __builtin_amdgcn_readlane((int)hv.z, L), h1 = __builtin_amdgcn_readlane((int)hv.y, L);
            int ab = pl - tl, b = 255 - 4 * L;
            if (ab + h3 < want) { ab += h3; --b; if (ab + h2 < want) { ab += h2; --b; if (ab + h1 < want) { ab += h1; --b; } } }
            bin = b; above = ab;
        };
        int B1, above1;
        {
            typedef short s16x2 __attribute__((ext_vector_type(2)));
#define SEL_PROBE(STRIDE, OUT, MIDV) do { \
                const unsigned t16_ = (unsigned)((MIDV) << 8) & 0xFFFFu; \
                const s16x2 tau2_ = __builtin_bit_cast(s16x2, t16_ | (t16_ << 16)); \
                s16x2 cn_ = (s16x2){0, 0}; \
                _Pragma("unroll") for (int j = 0; j < NP; j += (STRIDE)) { const s16x2 d_ = __builtin_elementwise_sub_sat(__builtin_bit_cast(s16x2, x[j]), tau2_); cn_ += d_ >> (s16x2){15, 15}; } \
                int c_ = (int)cn_.x + (int)cn_.y; \
                c_ += __builtin_amdgcn_update_dpp(0, c_, 0x111, 0xf, 0xf, false); c_ += __builtin_amdgcn_update_dpp(0, c_, 0x112, 0xf, 0xf, false); \
                c_ += __builtin_amdgcn_update_dpp(0, c_, 0x114, 0xf, 0xf, false); c_ += __builtin_amdgcn_update_dpp(0, c_, 0x118, 0xf, 0xf, false); \
                c_ += __builtin_amdgcn_update_dpp(0, c_, 0x142, 0xa, 0xf, false); c_ += __builtin_amdgcn_update_dpp(0, c_, 0x143, 0xc, 0xf, false); \
                OUT = 128 * (NP / (STRIDE)) + __builtin_amdgcn_readlane(c_, 63); } while (0)
            int g;
            { int slo = -128, shi = 128;
#pragma unroll 1
              for (int it = 0; it < 8; ++it) { const int mid = (slo + shi) >> 1; int ns; SEL_PROBE(4, ns, mid); if (ns >= 64) slo = mid; else shi = mid; }
              g = slo; }
            int lo = -128, hi = 128, chi = 0, step = 1, dir = 0;
#pragma unroll 1
            while (hi - lo > 1) {
                int mid = (lo + hi) >> 1;
                if (g > lo && g < hi) mid = g;
                int nge_; SEL_PROBE(1, nge_, mid);
                const bool ok = nge_ >= 256; const int d_ = ok ? 1 : -1;
                if (ok) lo = mid; else { hi = mid; chi = nge_; }
                if (g < 1000 && (dir == 0 || dir == d_)) { g = mid + d_ * step; if (dir != 0) step *= 2; dir = d_; } else g = 1000;
            }
#undef SEL_PROBE
            B1 = lo + 128; above1 = chi;
        }
        *(LAS u32x4*)(hist + 4 * ln) = (u32x4){0u, 0u, 0u, 0u};
        const int b1 = B1 - 128;
#pragma unroll
        for (int j = 0; j < NP; ++j) {
            if (__builtin_amdgcn_sbfe(x[j], 8, 8) == b1) __hip_atomic_fetch_add(hist + (x[j] & 0xFF), 1u, __ATOMIC_RELAXED, __HIP_MEMORY_SCOPE_WORKGROUP);
            if ((x[j] >> 24) == b1) __hip_atomic_fetch_add(hist + ((x[j] >> 16) & 0xFF), 1u, __ATOMIC_RELAXED, __HIP_MEMORY_SCOPE_WORKGROUP);
        }
        asm volatile("s_waitcnt lgkmcnt(0)" ::: "memory");
        int B2, above2; scan_find(256 - above1, B2, above2);
        const int neq = __builtin_amdgcn_readfirstlane((int)hist[B2]);
        asm volatile("s_waitcnt lgkmcnt(0)" ::: "memory");
        tauq = b1 * 256 + B2; nge = above1 + above2 + neq; exact = (nge == 256);
    }
    const int T = (int)((unsigned)tauq << 16);
    unsigned a0l = 0, a0h = 0, a1l = 0, a1h = 0;
    if (exact) {
        static_for_pairs<0, NP>([&](auto jc) { constexpr int j = decltype(jc)::value;
            const u64 ba = __ballot((int)((unsigned)x[j] << 16) >= T), bb = __ballot(x[j] >= T);
            putw<2 * j>(a0l, a0h, a1l, a1h, (unsigned)ba, (unsigned)bb); putw<2 * j + 1>(a0l, a0h, a1l, a1h, (unsigned)(ba >> 32), (unsigned)(bb >> 32));
            if ((j & 3) == 3) __builtin_amdgcn_sched_barrier(0); });
    } else {
        int tv = tauq; asm volatile("" : "+v"(tv)); const int tq2 = __builtin_amdgcn_readfirstlane(tv);
        int ngt = 0;
#pragma unroll
        for (int j = 0; j < NP; ++j) { ngt += __builtin_popcountll(__ballot(((int)((unsigned)x[j] << 16) >> 16) > tq2)) + __builtin_popcountll(__ballot((x[j] >> 16) > tq2)); if ((j & 3) == 3) __builtin_amdgcn_sched_barrier(0); }
        int need = 256 - ngt;
        int tv3 = tauq; asm volatile("" : "+v"(tv3)); const int tq3 = __builtin_amdgcn_readfirstlane(tv3);
        static_for_pairs<0, NP>([&](auto jc) { constexpr int j = decltype(jc)::value;
            const int lo = (int)((unsigned)x[j] << 16) >> 16, hi = x[j] >> 16;
            const u64 ga = __ballot(lo > tq3), gb = __ballot(hi > tq3), ea = __ballot(lo == tq3), eb = __ballot(hi == tq3);
            u64 gt0 = (ga & 0xFFFFFFFFull) | (gb << 32), gt1 = (ga >> 32) | (gb & 0xFFFFFFFF00000000ull);
            u64 eq0 = (ea & 0xFFFFFFFFull) | (eb << 32), eq1 = (ea >> 32) | (eb & 0xFFFFFFFF00000000ull);
            int ne = __builtin_popcountll(eq0);
            while (ne > need) { eq0 &= ~(1ull << (63 - __builtin_clzll(eq0))); --ne; }
            need -= ne;
            ne = __builtin_popcountll(eq1);
            while (ne > need) { eq1 &= ~(1ull << (63 - __builtin_clzll(eq1))); --ne; }
            need -= ne;
            const u64 w0 = gt0 | eq0, w1 = gt1 | eq1;
            putw<2 * j>(a0l, a0h, a1l, a1h, (unsigned)w0, (unsigned)(w0 >> 32)); putw<2 * j + 1>(a0l, a0h, a1l, a1h, (unsigned)w1, (unsigned)(w1 >> 32));
            __builtin_amdgcn_sched_barrier(0); });
    }
    brow[ln] = ((u64)a0h << 32) | a0l; brow[64 + ln] = ((u64)a1h << 32) | a1l;
}
__device__ __forceinline__ int sel_rowmap(int tt) { return ((tt >> 11) & 1) ? (tt | 2047) - (tt & 2047) : tt; }
__device__ __forceinline__ void phase_select(const Params& P, int chunk, LAS unsigned char* lds) {
    unsigned char* ws = opaque_ptr(P.ws); const int tid = opaque_tid(), lane = tid & 63, wv = tid >> 6;
    LAS unsigned* hist = (LAS unsigned*)(lds + 131072 + 8192) + wv * 256;
    const LAS unsigned* rbuf = (const LAS unsigned*)(lds + wv * 16384);
    const unsigned rlds = (unsigned)(uintptr_t)(lds + wv * 16384);
    const int gw = (o_blk() * 512 + tid) >> 6, ngw = (o_grid() * 512) >> 6;
    const unsigned* SC = (const unsigned*)(ws + WS_SC); u64* BITS = (u64*)(ws + WS_BITS);
    const int ta = ch_t(chunk), tb = ch_t(chunk + 1), nrows = tb - ta;
    int r = gw;
    if (r < BATCH * nrows) {
        const int ru = __builtin_amdgcn_readfirstlane(r); const int b = (ru >= nrows) ? 1 : 0, t = ta + sel_rowmap(ru - b * nrows);
        if (t >= 256) { const unsigned* src = SC + (size_t)b * SC_PB + sc_row(t); const int nd = 2 * ((t >> 10) + 1);
            for (int q = 0; q < nd; ++q) att::glds16(src + q * 256 + lane * 4, (unsigned)__builtin_amdgcn_readfirstlane(rlds + q * 1024)); }
    }
    for (; r < BATCH * nrows; r += ngw) {
        const int ru = __builtin_amdgcn_readfirstlane(r);
        const int b = (ru >= nrows) ? 1 : 0, t = ta + sel_rowmap(ru - b * nrows), row = b * SEQ + t;
        u64* brow = BITS + (size_t)row * 128;
        int ln = lane; asm volatile("" : "+v"(ln));
        const int rn = ru + ngw; int ndn = 0; const unsigned* nsrc = SC;
        if (rn < BATCH * nrows) { const int bn = (rn >= nrows) ? 1 : 0, tn = ta + sel_rowmap(rn - bn * nrows); if (tn >= 256) { ndn = 2 * ((tn >> 10) + 1); nsrc = SC + (size_t)bn * SC_PB + sc_row(tn); } }
        if (t < 256) {
            for (int w = ln; w < 128; w += 64) { const int lo = w * 64; u64 v = 0; if (t >= lo + 63) v = ~0ull; else if (t >= lo) v = (2ull << (t - lo)) - 1ull; brow[w] = v; }
            for (int q = 0; q < ndn; ++q) att::glds16(nsrc + q * 256 + ln * 4, (unsigned)__builtin_amdgcn_readfirstlane(rlds + q * 1024));
            continue;
        }
        asm volatile("s_waitcnt vmcnt(0)" ::: "memory");
        const int nq = t >> 10;
        if (nq == 0) select_row<8>(rbuf, brow, t, ln, hist, nsrc, rlds, ndn);
        else if (nq == 1) select_row<16>(rbuf, brow, t, ln, hist, nsrc, rlds, ndn);
        else if (nq == 2) select_row<24>(rbuf, brow, t, ln, hist, nsrc, rlds, ndn);
        else if (nq == 3) select_row<32>(rbuf, brow, t, ln, hist, nsrc, rlds, ndn);
        else if (nq == 4) select_row<40>(rbuf, brow, t, ln, hist, nsrc, rlds, ndn);
        else if (nq == 5) select_row<48>(rbuf, brow, t, ln, hist, nsrc, rlds, ndn);
        else if (nq == 6) select_row<56>(rbuf, brow, t, ln, hist, nsrc, rlds, ndn);
        else select_row<64>(rbuf, brow, t, ln, hist, nsrc, rlds, ndn);
    }
    asm volatile("s_waitcnt vmcnt(0)" ::: "memory");
}

__device__ __forceinline__ void phase_gate(const Params& P, LAS unsigned char* lds) {
    unsigned char* ws = opaque_ptr(P.ws);
    const int tid = opaque_tid();
    const f16* QA = (const f16*)(ws + WS_QA); const float* KM = (const float*)(ws + WS_KMEAN); unsigned* SEL = (unsigned*)(ws + WS_SEL);
    LAS float* kml = (LAS float*)lds;
    const int G_ = o_grid();
    for (int u = o_blk(); u < 256; u += G_) {
        const int bh = u >> 4, rc = u & 15, b = bh >> 3, h = bh & 7;
        const int t = tid * 16 + rc, row = b * SEQ + t, own = t >> 8;
        __syncthreads();
        { const int n = tid >> 4, c4 = (tid & 15) * 4; *(LAS f32x4*)(kml + n * 64 + c4) = *(const f32x4*)(KM + ((size_t)(b * 32 + n)) * 512 + h * 64 + c4); }
        __syncthreads();
        unsigned selm = 0;
        if (own <= 3) selm = (1u << own) - 1u;
        else {
            f16x8 q[8];
            const f16* qp = QA + (size_t)row * 512 + h * 64;
#pragma unroll
            for (int d = 0; d < 8; ++d) q[d] = *(const f16x8*)(qp + d * 8);
            float g0 = -INFINITY, g1 = -INFINITY, g2 = -INFINITY; int i0 = 0, i1 = 0, i2 = 0;
            for (int n = 0; n < own; ++n) {
                const LAS float* km = kml + n * 64; float a = 0.f;
#pragma unroll
                for (int d = 0; d < 8; ++d) { const f32x4 k0 = *(const LAS f32x4*)(km + d * 8), k1 = *(const LAS f32x4*)(km + d * 8 + 4);
                    a = __builtin_fmaf((float)q[d][0], k0[0], a); a = __builtin_fmaf((float)q[d][1], k0[1], a); a = __builtin_fmaf((float)q[d][2], k0[2], a); a = __builtin_fmaf((float)q[d][3], k0[3], a);
                    a = __builtin_fmaf((float)q[d][4], k1[0], a); a = __builtin_fmaf((float)q[d][5], k1[1], a); a = __builtin_fmaf((float)q[d][6], k1[2], a); a = __builtin_fmaf((float)q[d][7], k1[3], a); }
                if (a > g0) { g2 = g1; i2 = i1; g1 = g0; i1 = i0; g0 = a; i0 = n; }
                else if (a > g1) { g2 = g1; i2 = i1; g1 = a; i1 = n; }
                else if (a > g2) { g2 = a; i2 = n; }
            }
            selm = (1u << i0) | (1u << i1) | (1u << i2);
        }
        SEL[(size_t)row * 8 + h] = selm;
    }
}


namespace att {
typedef float f32x16 __attribute__((ext_vector_type(16)));
typedef short s16x4 __attribute__((ext_vector_type(4)));
typedef short v4i16_t __attribute__((ext_vector_type(4)));
constexpr int QBLK = 32, QB = 256, KVBLK = 64, PITCH = 512;
constexpr int SLOTB = 8192, LDS_K = 0, LDS_V = 3 * SLOTB, LDS_WS = 6 * SLOTB, LDS_OST = LDS_WS + 8 * 256, LDS_BYTES = LDS_OST + 8 * 4096;
constexpr int THR = 8;
#define SBAR() __builtin_amdgcn_sched_barrier(0)
#define PIN(x) asm volatile("" : "+v"(x))
#define MFMA(a, b, c) __builtin_amdgcn_mfma_f32_32x32x16_f16(a, b, c, 0, 0, 0)
#define WAIT_BARW(N) do { asm volatile("s_waitcnt vmcnt(" #N ") lgkmcnt(0)\n\ts_barrier" ::: "memory"); __builtin_amdgcn_sched_barrier(0); asm volatile("" : "+v"(wq)); } while (0)
__device__ __forceinline__ int crow(int r, int hi) { return (r & 3) + 8 * (r >> 2) + 4 * hi; }
__device__ __forceinline__ unsigned cvtpk(float lo, float hi) { return pk_f16(lo, hi); }
__device__ __forceinline__ void glds16(const void* g, unsigned lds_base) {
    unsigned sv; asm volatile("s_mov_b32 %0, m0\n\ts_mov_b32 m0, %2\n\ts_nop 0\n\tglobal_load_lds_dwordx4 %1, off\n\ts_mov_b32 m0, %0" : "=&s"(sv) : "v"(g), "s"(lds_base) : "memory"); }
typedef __attribute__((address_space(3))) const char* lds_cptr;
__device__ __forceinline__ void kload2(f16x8* kf, lds_cptr kp, int d0) { kf[2 * d0] = *(const __attribute__((address_space(3))) f16x8*)(kp + d0 * 2048); kf[2 * d0 + 1] = *(const __attribute__((address_space(3))) f16x8*)(kp + d0 * 2048 + 512); }
__device__ __forceinline__ s16x4 vtr(lds_cptr p) { return __builtin_bit_cast(s16x4, __builtin_amdgcn_ds_read_tr16_b64_v4i16((__attribute__((address_space(3))) v4i16_t*)p)); }
#define MX3(a, b, c) __builtin_fmaxf(__builtin_fmaxf((a), (b)), (c))
__device__ __forceinline__ float rowmax(const f32x16& p0, const f32x16& p1) {
    float a = MX3(p0[0], p0[1], p1[0]), b = MX3(p0[2], p0[3], p1[1]); a = MX3(a, p1[2], p1[3]);
#pragma unroll
    for (int r = 4; r < 16; r += 4) { a = MX3(a, p0[r], p0[r + 1]); b = MX3(b, p0[r + 2], p0[r + 3]); a = MX3(a, p1[r], p1[r + 1]); b = MX3(b, p1[r + 2], p1[r + 3]); }
    float m = __builtin_fmaxf(a, b); auto rr = __builtin_amdgcn_permlane32_swap(__float_as_uint(m), __float_as_uint(m), false, false);
    return __builtin_fmaxf(__uint_as_float(rr[0]), __uint_as_float(rr[1])); }
template <int POS> __device__ __forceinline__ float msk1(float p, unsigned w) { unsigned m; asm("v_bfe_i32 %0, %1, %2, 1" : "=v"(m) : "v"(w), "n"(POS)); return __uint_as_float(__float_as_uint(p) & m); }
#define MSK(P, i, w) P[i] = msk1<((i) & 3) + 8 * ((i) >> 2)>(P[i], (w))

typedef _Float16 h2_t __attribute__((ext_vector_type(2)));
__device__ __forceinline__ unsigned pkadd_h2(unsigned a, unsigned b) { return __builtin_bit_cast(unsigned, (h2_t)(__builtin_bit_cast(h2_t, a) + __builtin_bit_cast(h2_t, b))); }
__device__ __forceinline__ float hsum_h2(unsigned a) { const h2_t v = __builtin_bit_cast(h2_t, a); return (float)v.x + (float)v.y; }
constexpr int LDS_LUT = LDS_BYTES;
__device__ __forceinline__ void glds16s(const void* sbase, unsigned voff, unsigned lds_base) {
    unsigned sv; asm volatile("s_mov_b32 %0, m0\n\ts_mov_b32 m0, %3\n\ts_nop 0\n\tglobal_load_lds_dwordx4 %1, %2\n\ts_mov_b32 m0, %0" : "=&s"(sv) : "v"(voff), "s"(sbase), "s"(lds_base) : "memory"); }
template <int MODE>
__device__ __forceinline__ void attn_unit(int b, int h, int qb, const f16* Q, const f16* __restrict__ K, const f16* __restrict__ V, const f16* G, f16* Y, int coff,
                                          const u64* BITS, const unsigned* SEL, char* lds) {
    const int tid = opaque_tid(), lane = tid & 63, r32 = lane & 31, hi = lane >> 5; const int wid = __builtin_amdgcn_readfirstlane(tid >> 6);
    const long rowbase = (long)b * SEQ; const int q0 = qb * QB, NT = (q0 + QB) / KVBLK;
    const f16* Qw = Q + (rowbase + q0 + wid * QBLK) * PITCH + h * 64;
    const unsigned lds0 = (unsigned)(uintptr_t)lds; float* wsf = (float*)(lds + LDS_WS) + wid * 64;
    const f16* kbase = K + rowbase * PITCH + h * 64; const f16* vbase = V + rowbase * PITCH + h * 64;
    const unsigned koff = (unsigned)(lane * PITCH + wid * 8) * 2u, voff = (unsigned)((16 * (wid & 3) + (lane >> 2)) * PITCH + (wid >> 2) * 32 + (lane & 3) * 8) * 2u;
    const unsigned kdst = lds0 + LDS_K + wid * 1024, vdst = lds0 + LDS_V + wid * 1024;
#define DMA_K(t, slot) glds16s(kbase + (long)(t) * KVBLK * PITCH, koff, (unsigned)__builtin_amdgcn_readfirstlane(kdst + (slot)))
#define DMA_V(t, slot) glds16s(vbase + (long)(t) * KVBLK * PITCH, voff, (unsigned)__builtin_amdgcn_readfirstlane(vdst + (slot)))
    const lds_cptr vp0 = (lds_cptr)lds + LDS_V + ((lane >> 4) & 1) * 32 + (lane & 3) * 8 + (4 * hi + ((lane & 15) >> 2)) * 64;
    const lds_cptr kp0 = (lds_cptr)lds + LDS_K + hi * 1024 + r32 * 16;
    const int tq = q0 + wid * QBLK + r32;
    const u64* wbase = BITS + (size_t)rowbase * 128; const unsigned woff = (unsigned)tq * 1024u;
    unsigned selm = 0; if (MODE == 1) selm = SEL[(size_t)(rowbase + tq) * 8 + h];
    u64 wq = 0; unsigned w8lo = 0, w8hi = 0;
    const lds_cptr lutp = (lds_cptr)lds + LDS_LUT;
    if (tid < 16) { const unsigned a_ = ((tid & 1) ? 0xFFFFu : 0u) | ((tid & 2) ? 0xFFFF0000u : 0u), b_ = ((tid & 4) ? 0xFFFFu : 0u) | ((tid & 8) ? 0xFFFF0000u : 0u);
                    *(u32x2*)(lds + LDS_LUT + tid * 8) = (u32x2){a_, b_}; }
#define LUTRD(w8, g) (*(const __attribute__((address_space(3))) u32x2*)(lutp + __builtin_amdgcn_ubfe((w8), 8 * (g), 8)))
#define MASKP(LM, PW, a, b) do { PW[a] &= LM[0]; PW[b] &= LM[1]; sacc = pkadd_h2(pkadd_h2(sacc, PW[a]), PW[b]); } while (0)
#define WGET(t) do { if (MODE == 0) { asm volatile("global_load_dwordx2 %0, %1, %2" : "=v"(wq) : "v"(woff), "s"(wbase + (t)) : "memory"); } \
                     else { const int blk_ = (t) >> 2; const int d_ = tq - 64 * (t); \
                            const u64 tri_ = d_ >= 63 ? ~0ull : (d_ < 0 ? 0ull : ((2ull << d_) - 1ull)); \
                            wq = (blk_ == qb) ? tri_ : (((selm >> blk_) & 1u) ? ~0ull : 0ull); } } while (0)
#define WSET() do { w8lo = (((unsigned)wq >> (4 * hi)) & 0x0F0F0F0Fu) << 3; w8hi = (((unsigned)(wq >> 32) >> (4 * hi)) & 0x0F0F0F0Fu) << 3; } while (0)
    WGET(0);
    DMA_K(0, 0); DMA_V(0, 0); DMA_K(1, SLOTB);
    f16x8 qr[4];
#pragma unroll
    for (int d0 = 0; d0 < 4; ++d0) qr[d0] = *reinterpret_cast<const f16x8*>(&Qw[(long)r32 * PITCH + d0 * 16 + hi * 8]);
    float mhat = 0.f, l_reg = 0.f; f32x16 o[2]; o[0] = zero16_here(); o[1] = o[0];
    f32x16 negm = o[0]; PIN(negm);
    bool resc = false;
    f32x16 pA0, pA1, pB0, pB1; f16x8 kf[4]; s16x4 vlo[3], vhi[3]; u32x4 pw0, pw1, pw2, pw3;
    int sl_prev = 0, sl_cur = 0, sl_next = SLOTB;
#define ROT() do { sl_prev = sl_cur; sl_cur = sl_next; sl_next = (sl_next == 2 * SLOTB) ? 0 : sl_next + SLOTB; } while (0)
#define EX(v) __builtin_amdgcn_exp2f(v)
#define RESC() do { if (resc) { _Pragma("unroll") for (int d_ = 0; d_ < 2; ++d_) _Pragma("unroll") for (int r = 0; r < 16; ++r) o[d_][r] *= wsf[crow(r, hi)]; } } while (0)
    DMA_K(2, 2 * SLOTB);
    WAIT_BARW(3);
    WSET();
#define KLD(kp, d0) do { kf[2 * ((d0) & 1)] = *(const __attribute__((address_space(3))) f16x8*)((kp) + (d0) * 2048); kf[2 * ((d0) & 1) + 1] = *(const __attribute__((address_space(3))) f16x8*)((kp) + (d0) * 2048 + 512); } while (0)
    KLD(kp0, 0); KLD(kp0, 1);
    pA0 = MFMA(kf[0], qr[0], negm); pA1 = MFMA(kf[1], qr[0], negm); SBAR(); KLD(kp0, 2); pA0 = MFMA(kf[2], qr[1], pA0); pA1 = MFMA(kf[3], qr[1], pA1); SBAR(); KLD(kp0, 3);
    pA0 = MFMA(kf[0], qr[2], pA0); pA1 = MFMA(kf[1], qr[2], pA1); pA0 = MFMA(kf[2], qr[3], pA0); pA1 = MFMA(kf[3], qr[3], pA1);
    { const float rm = rowmax(pA0, pA1); mhat = rm;
#pragma unroll
      for (int r = 0; r < 16; ++r) negm[r] = -mhat;
      PIN(negm);
#pragma unroll
      for (int r = 0; r < 16; ++r) { pA0[r] = EX(pA0[r] - rm); pA1[r] = EX(pA1[r] - rm); } }
    WAIT_BARW(0);
    DMA_K(3, 0); DMA_V(1, SLOTB); ROT();
    KLD(kp0 + sl_cur, 0); KLD(kp0 + sl_cur, 1);
    WAIT_BARW(2);
#define PKW(P, i) cvtpk(P[i], P[i + 1])
#define PAF(k) __builtin_bit_cast(f16x8, pw##k)
#define VFRS(sl_) __builtin_bit_cast(f16x8, (short __attribute__((ext_vector_type(8)))){vlo[sl_][0], vlo[sl_][1], vlo[sl_][2], vlo[sl_][3], vhi[sl_][0], vhi[sl_][1], vhi[sl_][2], vhi[sl_][3]})
#define VRDS(sl_, i) do { vlo[sl_] = vtr(vp_ + (((i) >> 2) * 4096 + ((i) & 3) * 1024)); vhi[sl_] = vtr(vp_ + (((i) >> 2) * 4096 + ((i) & 3) * 1024 + 512)); } while (0)
#define KRD(Gx, d0) do { if (Gx) { KLD(kp0 + sl_next, d0); SBAR(); } } while (0)
#define GAPA(MF, P, i, PWa, PWb, X) do { MF; PWa = PKW(P, i); PWb = PKW(P, (i) + 2); X; PIN(sacc); SBAR(); } while (0)
#define GAPB(MF, X, i, Y) do { MF; X[i] = EX(X[i]); X[i + 1] = EX(X[i + 1]); X[i + 2] = EX(X[i + 2]); X[i + 3] = EX(X[i + 3]); Y; PIN(X); PIN(sacc); SBAR(); } while (0)
#define STEP(C0, C1, P0, P1, t, GK, GV, GL) do { SBAR(); \
    WGET(t);                                                             \
    SBAR(); \
    const lds_cptr vp_ = vp0 + sl_prev; \
    unsigned sacc = 0u; u32x2 lm0, lm1, lm2, lm3, lm4, lm5, lm6, lm7; float fl = 1.0f; \
    GAPA(C0 = MFMA(kf[0], qr[0], negm), P0, 0,  pw0[0], pw0[1], lm0 = LUTRD(w8lo, 0)); \
    GAPA(C1 = MFMA(kf[1], qr[0], negm), P0, 4,  pw0[2], pw0[3], lm1 = LUTRD(w8lo, 1)); \
    GAPA(C0 = MFMA(kf[2], qr[1], C0),    P0, 8,  pw1[0], pw1[1], KLD(kp0 + sl_cur, 2); MASKP(lm0, pw0, 0, 1); lm2 = LUTRD(w8lo, 2)); \
    GAPA(C1 = MFMA(kf[3], qr[1], C1),    P0, 12, pw1[2], pw1[3], MASKP(lm1, pw0, 2, 3); lm3 = LUTRD(w8lo, 3)); \
    GAPA(C0 = MFMA(kf[0], qr[2], C0),    P1, 0,  pw2[0], pw2[1], KLD(kp0 + sl_cur, 3); MASKP(lm2, pw1, 0, 1); lm4 = LUTRD(w8hi, 0)); \
    GAPA(C1 = MFMA(kf[1], qr[2], C1),    P1, 4,  pw2[2], pw2[3], MASKP(lm3, pw1, 2, 3); lm5 = LUTRD(w8hi, 1)); \
    GAPA(C0 = MFMA(kf[2], qr[3], C0),    P1, 8,  pw3[0], pw3[1], MASKP(lm4, pw2, 0, 1); lm6 = LUTRD(w8hi, 2); VRDS(0, 0)); \
    GAPA(C1 = MFMA(kf[3], qr[3], C1),    P1, 12, pw3[2], pw3[3], MASKP(lm5, pw2, 2, 3); lm7 = LUTRD(w8hi, 3); VRDS(1, 4)); \
    if (GK) DMA_K((t) + 3, sl_cur); if (GV) DMA_V((t) + 1, sl_next); \
    { const float rm = rowmax(C0, C1); resc = false;                                    \
      if (__builtin_expect(__any(rm > (float)THR), 0)) { const float dl = __builtin_fmaxf(rm, 0.f); mhat += dl; \
          _Pragma("unroll") for (int r = 0; r < 16; ++r) { C0[r] -= dl; C1[r] -= dl; } \
          _Pragma("unroll") for (int r = 0; r < 16; ++r) negm[r] = -mhat; \
          PIN(negm); \
          const float f = __builtin_amdgcn_exp2f(-dl); l_reg *= f; fl = f; if (hi == 0) wsf[r32] = f; resc = true; } } \
    SBAR(); \
    GAPB(o[0] = MFMA(PAF(0), VFRS(0), o[0]), C0, 0, MASKP(lm6, pw3, 0, 1); VRDS(2, 1));  GAPB(o[1] = MFMA(PAF(0), VFRS(1), o[1]), C0, 4, MASKP(lm7, pw3, 2, 3); VRDS(0, 5)); \
    KRD(GL, 0); GAPB(o[0] = MFMA(PAF(1), VFRS(2), o[0]), C0, 8, VRDS(1, 2));  KRD(GL, 1); GAPB(o[1] = MFMA(PAF(1), VFRS(0), o[1]), C0, 12, VRDS(2, 6)); \
    GAPB(o[0] = MFMA(PAF(2), VFRS(1), o[0]), C1, 0, VRDS(0, 3));  GAPB(o[1] = MFMA(PAF(2), VFRS(2), o[1]), C1, 4, VRDS(1, 7)); \
    l_reg += hsum_h2(sacc) * fl;                                         \
    GAPB(o[0] = MFMA(PAF(3), VFRS(0), o[0]), C1, 8, (void)0);     GAPB(o[1] = MFMA(PAF(3), VFRS(1), o[1]), C1, 12, (void)0); \
    } while (0)
    int t = 1;
    for (; t + 5 < NT; t += 2) {
        STEP(pB0, pB1, pA0, pA1, t, true, true, true);     WAIT_BARW(2); WSET(); RESC(); ROT();
        STEP(pA0, pA1, pB0, pB1, t + 1, true, true, true); WAIT_BARW(2); WSET(); RESC(); ROT();
    }
#define ENDW(tt) do { if ((tt) + 3 < NT) { WAIT_BARW(2); } else if ((tt) + 2 < NT) { WAIT_BARW(1); } else { WAIT_BARW(0); } } while (0)
    for (; t + 1 < NT; t += 2) {
        STEP(pB0, pB1, pA0, pA1, t, (t + 3 < NT), (t + 1 < NT), (t + 1 < NT));         ENDW(t);     WSET(); RESC(); ROT();
        STEP(pA0, pA1, pB0, pB1, t + 1, (t + 4 < NT), (t + 2 < NT), (t + 2 < NT));     ENDW(t + 1); WSET(); RESC(); ROT();
    }
    STEP(pB0, pB1, pA0, pA1, NT - 1, false, false, false);
    asm volatile("s_waitcnt vmcnt(0)" ::: "memory"); __builtin_amdgcn_sched_barrier(0); asm volatile("" : "+v"(wq));
    WSET(); RESC();
    {
      pw0 = (u32x4){PKW(pB0, 0), PKW(pB0, 2), PKW(pB0, 4), PKW(pB0, 6)}; pw1 = (u32x4){PKW(pB0, 8), PKW(pB0, 10), PKW(pB0, 12), PKW(pB0, 14)};
      pw2 = (u32x4){PKW(pB1, 0), PKW(pB1, 2), PKW(pB1, 4), PKW(pB1, 6)}; pw3 = (u32x4){PKW(pB1, 8), PKW(pB1, 10), PKW(pB1, 12), PKW(pB1, 14)};
      unsigned sacc = 0u;
      { const u32x2 l0 = LUTRD(w8lo, 0), l1 = LUTRD(w8lo, 1), l2 = LUTRD(w8lo, 2), l3 = LUTRD(w8lo, 3), l4 = LUTRD(w8hi, 0), l5 = LUTRD(w8hi, 1), l6 = LUTRD(w8hi, 2), l7 = LUTRD(w8hi, 3);
        MASKP(l0, pw0, 0, 1); MASKP(l1, pw0, 2, 3); MASKP(l2, pw1, 0, 1); MASKP(l3, pw1, 2, 3); MASKP(l4, pw2, 0, 1); MASKP(l5, pw2, 2, 3); MASKP(l6, pw3, 0, 1); MASKP(l7, pw3, 2, 3); }
      l_reg += hsum_h2(sacc);
      const lds_cptr vp_ = vp0 + sl_cur;
      VRDS(0, 0); VRDS(1, 4); VRDS(2, 1);
      o[0] = MFMA(PAF(0), VFRS(0), o[0]); SBAR(); VRDS(0, 5); o[1] = MFMA(PAF(0), VFRS(1), o[1]); SBAR(); VRDS(1, 2); o[0] = MFMA(PAF(1), VFRS(2), o[0]); SBAR(); VRDS(2, 6);
      o[1] = MFMA(PAF(1), VFRS(0), o[1]); SBAR(); VRDS(0, 3); o[0] = MFMA(PAF(2), VFRS(1), o[0]); SBAR(); VRDS(1, 7); o[1] = MFMA(PAF(2), VFRS(2), o[1]); SBAR();
      o[0] = MFMA(PAF(3), VFRS(0), o[0]); o[1] = MFMA(PAF(3), VFRS(1), o[1]); }
    { auto rr = __builtin_amdgcn_permlane32_swap(__float_as_uint(l_reg), __float_as_uint(l_reg), false, false); l_reg = __uint_as_float(rr[0]) + __uint_as_float(rr[1]); }
    if (hi == 0) wsf[32 + r32] = l_reg; asm volatile("s_waitcnt lgkmcnt(0)" ::: "memory");
    float rli[16];
#pragma unroll
    for (int r = 0; r < 16; ++r) rli[r] = __builtin_amdgcn_rcpf(wsf[32 + crow(r, hi)]);
    f16* stg = (f16*)(lds + LDS_OST) + wid * 2048;
#pragma unroll
    for (int r = 0; r < 16; ++r) { const int orow = crow(r, hi);
#pragma unroll
        for (int d0 = 0; d0 < 2; ++d0) stg[orow * 64 + d0 * 32 + r32] = (f16)(o[d0][r] * rli[r]); }
    asm volatile("s_waitcnt lgkmcnt(0)" ::: "memory");
    const size_t yb = (size_t)(rowbase + q0 + wid * QBLK) * 1536 + coff + h * 64;
#pragma unroll
    for (int i = 0; i < 4; ++i) { const int row = i * 8 + (lane >> 3), ch = lane & 7;
        const f16x8 ov = *(const f16x8*)(stg + row * 64 + ch * 8); const f16x8 gv = *(const f16x8*)(G + yb + (size_t)row * 1536 + ch * 8);
        u32x4 w; w.x = pk_f16((float)ov[0] * (float)gv[0], (float)ov[1] * (float)gv[1]); w.y = pk_f16((float)ov[2] * (float)gv[2], (float)ov[3] * (float)gv[3]);
        w.z = pk_f16((float)ov[4] * (float)gv[4], (float)ov[5] * (float)gv[5]); w.w = pk_f16((float)ov[6] * (float)gv[6], (float)ov[7] * (float)gv[7]);
        *(u32x4*)(Y + yb + (size_t)row * 1536 + ch * 8) = w; }
    asm volatile("s_waitcnt lgkmcnt(0)\n\ts_barrier" ::: "memory");
#undef DMA_K
#undef DMA_V
#undef ROT
#undef EX
#undef RESC
#undef PKW
#undef PAF
#undef VFRS
#undef VRDS
#undef KRD
#undef GAPA
#undef GAPB
#undef STEP
#undef ENDW
#undef WGET
#undef WSET
}
constexpr int R_K = 0, R_V = 32768, R_WS = 65536, R_OST = R_WS + 8 * 256, R_Q = R_OST + 8 * 4096, R_DT = R_Q + 8 * 1024, R_END = R_DT + 8 * 128;
template <bool CAUSAL>
__device__ __forceinline__ void moba_item(int rowg, int tloc, unsigned dent, int h, const f16* Q, f16* PO, float* PML, char* lds, int wid, int lane) {
    const int r32 = lane & 31, hi = lane >> 5;
    float* wsf = (float*)(lds + R_WS) + wid * 64;
    unsigned* dtab = (unsigned*)(lds + R_DT) + wid * 32;
    const lds_cptr kp0 = (lds_cptr)lds + R_K + hi * 1024 + r32 * 16;
    const lds_cptr vp0 = (lds_cptr)lds + R_V + ((lane >> 4) & 1) * 32 + (lane & 3) * 8 + (4 * hi + ((lane & 15) >> 2)) * 64;
    if (hi == 0) dtab[r32] = dent;
    f16x8 qr[4];
#pragma unroll
    for (int d0 = 0; d0 < 4; ++d0) qr[d0] = *reinterpret_cast<const f16x8*>(Q + (size_t)rowg * PITCH + h * 64 + d0 * 16 + hi * 8);
    float mhat = 0.f, l_reg = 0.f; f32x16 o[2]; o[0] = zero16_here(); o[1] = o[0];
    f32x16 negm = o[0]; PIN(negm);
    bool resc = false;
    f32x16 pA0, pA1, pB0, pB1; f16x8 kf[8]; s16x4 vlo[8], vhi[8]; u32x4 pw0, pw1, pw2, pw3;
    unsigned mlo = 0, mhi = 0;
#define RW(t) do { if (CAUSAL) { const int d_ = tloc - 64 * (t); const u64 w_ = d_ >= 63 ? ~0ull : (d_ < 0 ? 0ull : ((2ull << d_) - 1ull)); mlo = (unsigned)w_ >> (4 * hi); mhi = (unsigned)(w_ >> 32) >> (4 * hi); } } while (0)
#define EX(v) __builtin_amdgcn_exp2f(v)
#define RESC() do { if (resc) { asm volatile("s_waitcnt lgkmcnt(0)" ::: "memory"); _Pragma("unroll") for (int d_ = 0; d_ < 2; ++d_) _Pragma("unroll") for (int r = 0; r < 16; ++r) o[d_][r] *= wsf[crow(r, hi)]; } } while (0)
    _Pragma("unroll") for (int d0 = 0; d0 < 4; ++d0) kload2(kf, kp0, d0);
    pA0 = MFMA(kf[0], qr[0], negm); pA1 = MFMA(kf[1], qr[0], negm); pA0 = MFMA(kf[2], qr[1], pA0); pA1 = MFMA(kf[3], qr[1], pA1);
    pA0 = MFMA(kf[4], qr[2], pA0); pA1 = MFMA(kf[5], qr[2], pA1); pA0 = MFMA(kf[6], qr[3], pA0); pA1 = MFMA(kf[7], qr[3], pA1);
    { const float rm = rowmax(pA0, pA1); mhat = rm;
#pragma unroll
      for (int r = 0; r < 16; ++r) negm[r] = -mhat;
      PIN(negm);
#pragma unroll
      for (int r = 0; r < 16; ++r) { pA0[r] = EX(pA0[r] - rm); pA1[r] = EX(pA1[r] - rm); } }
    _Pragma("unroll") for (int d0 = 0; d0 < 4; ++d0) kload2(kf, kp0 + 8192, d0);
#define PKW(P, i) cvtpk(P[i], P[i + 1])
#define PAF(k) __builtin_bit_cast(f16x8, pw##k)
#define VFR(i) __builtin_bit_cast(f16x8, (short __attribute__((ext_vector_type(8)))){vlo[i][0], vlo[i][1], vlo[i][2], vlo[i][3], vhi[i][0], vhi[i][1], vhi[i][2], vhi[i][3]})
#define VRD(i) do { vlo[i] = vtr(vp_ + (((i) >> 2) * 4096 + ((i) & 3) * 1024)); vhi[i] = vtr(vp_ + (((i) >> 2) * 4096 + ((i) & 3) * 1024 + 512)); } while (0)
#define KRD(Gx, t, d0) do { if (Gx) { kload2(kf, kp0 + ((t) + 1) * 8192, d0); SBAR(); } } while (0)
#define MC(P, i, w) do { if (CAUSAL) { MSK(P, i, w); } } while (0)
#define GAPA(MF, M0, M1, M2, M3, a0, a1, a2, a3, W0, W1, PW) do { MF; M0; M1; M2; M3; sacc = pkadd_h2(pkadd_h2(sacc, (W0)), (W1)); PIN(PW); PIN(sacc); SBAR(); } while (0)
#define GAPB(MF, X, i) do { MF; X[i] = EX(X[i]); X[i + 1] = EX(X[i + 1]); X[i + 2] = EX(X[i + 2]); X[i + 3] = EX(X[i + 3]); PIN(X); SBAR(); } while (0)
#define RSTEP(C0, C1, P0, P1, t, GL) do { SBAR(); \
    const lds_cptr vp_ = vp0 + ((t) - 1) * 8192; \
    RW((t) - 1); \
    MC(P0, 0, mlo); MC(P0, 1, mlo); \
    VRD(0); SBAR(); unsigned sacc = 0u; \
                    GAPA(C0 = MFMA(kf[0], qr[0], negm), MC(P0, 2, mlo), MC(P0, 3, mlo), MC(P0, 4, mlo), MC(P0, 5, mlo), P0[2], P0[3], P0[4], P0[5],     pw0[0] = PKW(P0, 0),  pw0[1] = PKW(P0, 2),  pw0); \
    VRD(4); SBAR(); GAPA(C1 = MFMA(kf[1], qr[0], negm), MC(P0, 6, mlo), MC(P0, 7, mlo), MC(P0, 8, mlo), MC(P0, 9, mlo), P0[6], P0[7], P0[8], P0[9],     pw0[2] = PKW(P0, 4),  pw0[3] = PKW(P0, 6),  pw0); \
    VRD(1); SBAR(); GAPA(C0 = MFMA(kf[2], qr[1], C0),    MC(P0, 10, mlo), MC(P0, 11, mlo), MC(P0, 12, mlo), MC(P0, 13, mlo), P0[10], P0[11], P0[12], P0[13], pw1[0] = PKW(P0, 8),  pw1[1] = PKW(P0, 10), pw1); \
    VRD(5); SBAR(); GAPA(C1 = MFMA(kf[3], qr[1], C1),    MC(P0, 14, mlo), MC(P0, 15, mlo), MC(P1, 0, mhi), MC(P1, 1, mhi), P0[14], P0[15], P1[0], P1[1],   pw1[2] = PKW(P0, 12), pw1[3] = PKW(P0, 14), pw1); \
    VRD(2); SBAR(); GAPA(C0 = MFMA(kf[4], qr[2], C0),    MC(P1, 2, mhi), MC(P1, 3, mhi), MC(P1, 4, mhi), MC(P1, 5, mhi), P1[2], P1[3], P1[4], P1[5],     pw2[0] = PKW(P1, 0),  pw2[1] = PKW(P1, 2),  pw2); \
    VRD(6); SBAR(); GAPA(C1 = MFMA(kf[5], qr[2], C1),    MC(P1, 6, mhi), MC(P1, 7, mhi), MC(P1, 8, mhi), MC(P1, 9, mhi), P1[6], P1[7], P1[8], P1[9],     pw2[2] = PKW(P1, 4),  pw2[3] = PKW(P1, 6),  pw2); \
    VRD(3); SBAR(); GAPA(C0 = MFMA(kf[6], qr[3], C0),    MC(P1, 10, mhi), MC(P1, 11, mhi), MC(P1, 12, mhi), MC(P1, 13, mhi), P1[10], P1[11], P1[12], P1[13], pw3[0] = PKW(P1, 8),  pw3[1] = PKW(P1, 10), pw3); \
    VRD(7); SBAR(); GAPA(C1 = MFMA(kf[7], qr[3], C1),    MC(P1, 14, mhi), MC(P1, 15, mhi), (void)0, (void)0, P1[14], P1[15], 0.f, 0.f,       pw3[2] = PKW(P1, 12), pw3[3] = PKW(P1, 14), pw3); \
    l_reg += hsum_h2(sacc); \
    { const float rm = rowmax(C0, C1); resc = false; \
      if (__builtin_expect(__any(rm > (float)THR), 0)) { const float dl = __builtin_fmaxf(rm, 0.f); mhat += dl; \
          _Pragma("unroll") for (int r = 0; r < 16; ++r) { C0[r] -= dl; C1[r] -= dl; } \
          _Pragma("unroll") for (int r = 0; r < 16; ++r) negm[r] = -mhat; \
          PIN(negm); \
          const float f = __builtin_amdgcn_exp2f(-dl); l_reg *= f; if (hi == 0) wsf[r32] = f; resc = true; } } \
    SBAR(); \
    GAPB(o[0] = MFMA(PAF(0), VFR(0), o[0]), C0, 0);              GAPB(o[1] = MFMA(PAF(0), VFR(4), o[1]), C0, 4); \
    KRD(GL, t, 0); GAPB(o[0] = MFMA(PAF(1), VFR(1), o[0]), C0, 8);  KRD(GL, t, 1); GAPB(o[1] = MFMA(PAF(1), VFR(5), o[1]), C0, 12); \
    KRD(GL, t, 2); GAPB(o[0] = MFMA(PAF(2), VFR(2), o[0]), C1, 0);  KRD(GL, t, 3); GAPB(o[1] = MFMA(PAF(2), VFR(6), o[1]), C1, 4); \
    GAPB(o[0] = MFMA(PAF(3), VFR(3), o[0]), C1, 8);              GAPB(o[1] = MFMA(PAF(3), VFR(7), o[1]), C1, 12); \
    } while (0)
    RSTEP(pB0, pB1, pA0, pA1, 1, true);  RESC();
    RSTEP(pA0, pA1, pB0, pB1, 2, true);  RESC();
    RSTEP(pB0, pB1, pA0, pA1, 3, false); RESC();
    { RW(3);
      MC(pB0, 0, mlo); MC(pB0, 1, mlo); MC(pB0, 2, mlo); MC(pB0, 3, mlo); MC(pB0, 4, mlo); MC(pB0, 5, mlo); MC(pB0, 6, mlo); MC(pB0, 7, mlo);
      MC(pB0, 8, mlo); MC(pB0, 9, mlo); MC(pB0, 10, mlo); MC(pB0, 11, mlo); MC(pB0, 12, mlo); MC(pB0, 13, mlo); MC(pB0, 14, mlo); MC(pB0, 15, mlo);
      MC(pB1, 0, mhi); MC(pB1, 1, mhi); MC(pB1, 2, mhi); MC(pB1, 3, mhi); MC(pB1, 4, mhi); MC(pB1, 5, mhi); MC(pB1, 6, mhi); MC(pB1, 7, mhi);
      MC(pB1, 8, mhi); MC(pB1, 9, mhi); MC(pB1, 10, mhi); MC(pB1, 11, mhi); MC(pB1, 12, mhi); MC(pB1, 13, mhi); MC(pB1, 14, mhi); MC(pB1, 15, mhi);
      pw0 = (u32x4){PKW(pB0, 0), PKW(pB0, 2), PKW(pB0, 4), PKW(pB0, 6)}; pw1 = (u32x4){PKW(pB0, 8), PKW(pB0, 10), PKW(pB0, 12), PKW(pB0, 14)};
      pw2 = (u32x4){PKW(pB1, 0), PKW(pB1, 2), PKW(pB1, 4), PKW(pB1, 6)}; pw3 = (u32x4){PKW(pB1, 8), PKW(pB1, 10), PKW(pB1, 12), PKW(pB1, 14)};
      unsigned sacc = 0u;
#pragma unroll
      for (int r = 0; r < 4; ++r) sacc = pkadd_h2(pkadd_h2(sacc, pw0[r]), pw1[r]);
#pragma unroll
      for (int r = 0; r < 4; ++r) sacc = pkadd_h2(pkadd_h2(sacc, pw2[r]), pw3[r]);
      l_reg += hsum_h2(sacc);
      const lds_cptr vp_ = vp0 + 3 * 8192; _Pragma("unroll") for (int i = 0; i < 8; ++i) VRD(i);
      o[0] = MFMA(PAF(0), VFR(0), o[0]); o[1] = MFMA(PAF(0), VFR(4), o[1]); o[0] = MFMA(PAF(1), VFR(1), o[0]); o[1] = MFMA(PAF(1), VFR(5), o[1]);
      o[0] = MFMA(PAF(2), VFR(2), o[0]); o[1] = MFMA(PAF(2), VFR(6), o[1]); o[0] = MFMA(PAF(3), VFR(3), o[0]); o[1] = MFMA(PAF(3), VFR(7), o[1]); }
    { auto rr = __builtin_amdgcn_permlane32_swap(__float_as_uint(l_reg), __float_as_uint(l_reg), false, false); l_reg = __uint_as_float(rr[0]) + __uint_as_float(rr[1]); }
    if (hi == 0) { wsf[32 + r32] = l_reg; if (dent != ~0u) { PML[(size_t)dent * 2] = mhat; PML[(size_t)dent * 2 + 1] = l_reg; } }
    asm volatile("s_waitcnt lgkmcnt(0)" ::: "memory");
    float rli[16];
#pragma unroll
    for (int r = 0; r < 16; ++r) rli[r] = __builtin_amdgcn_rcpf(wsf[32 + crow(r, hi)]);
    f16* stg = (f16*)(lds + R_OST) + wid * 2048;
#pragma unroll
    for (int r = 0; r < 16; ++r) { const int orow = crow(r, hi);
#pragma unroll
        for (int d0 = 0; d0 < 2; ++d0) stg[orow * 64 + d0 * 32 + r32] = (f16)(o[d0][r] * rli[r]); }
    asm volatile("s_waitcnt lgkmcnt(0)" ::: "memory");
#pragma unroll
    for (int i = 0; i < 4; ++i) { const int row = i * 8 + (lane >> 3), ch = lane & 7; const unsigned de = dtab[row];
        if (de != ~0u) *(u32x4*)(PO + (size_t)de * 64 + ch * 8) = *(const u32x4*)(stg + row * 64 + ch * 8); }
    asm volatile("s_waitcnt lgkmcnt(0)" ::: "memory");
#undef RW
#undef EX
#undef RESC
#undef PKW
#undef PAF
#undef VFR
#undef VRD
#undef KRD
#undef MC
#undef GAPA
#undef GAPB
#undef RSTEP
}
__device__ __forceinline__ int moba_nseg(int j) { const int n = (7936 - 256 * j + 2047) >> 11; return n < 1 ? 1 : n; }
__device__ __forceinline__ void moba_kv_unit(int bh, int j, const f16* Q, const f16* K, const f16* V, const unsigned* SEL, f16* PO, float* PML, char* lds) {
    const int tid = opaque_tid(), lane = tid & 63, r32 = lane & 31; const int wid = __builtin_amdgcn_readfirstlane(tid >> 6);
    const int b = bh >> 3, h = bh & 7; const long rowbase = (long)b * SEQ;
    const unsigned lds0 = (unsigned)(uintptr_t)lds;
    unsigned* qcnt = (unsigned*)(lds + 131072 + 4096 + 40);
    { const f16* ksrc = K + (rowbase + 256 * j + lane) * PITCH + h * 64 + wid * 8;
      const f16* vsrc = V + (rowbase + 256 * j + 16 * (wid & 3) + (lane >> 2)) * PITCH + h * 64 + (wid >> 2) * 32 + (lane & 3) * 8;
#pragma unroll
      for (int t = 0; t < 4; ++t) { glds16(ksrc + (long)t * 64 * PITCH, (unsigned)__builtin_amdgcn_readfirstlane(lds0 + R_K + t * 8192 + wid * 1024));
                                    glds16(vsrc + (long)t * 64 * PITCH, (unsigned)__builtin_amdgcn_readfirstlane(lds0 + R_V + t * 8192 + wid * 1024)); }
      if (tid == 0) *qcnt = 0u;
      asm volatile("s_waitcnt vmcnt(0) lgkmcnt(0)\n\ts_barrier" ::: "memory"); }
    unsigned short* qu16 = (unsigned short*)(lds + R_END);
    const int nch = 4 * (31 - j);
    for (int c0 = wid; c0 < nch; c0 += 32) {
        unsigned selw[4];
#pragma unroll
        for (int w = 0; w < 4; ++w) { const int c = c0 + 8 * w; const int t = 256 * (j + 1) + 64 * c + lane; selw[w] = (c < nch) ? SEL[(size_t)(rowbase + t) * 8 + h] : 0u; }
#pragma unroll
        for (int w = 0; w < 4; ++w) { const int c = c0 + 8 * w; const int t = 256 * (j + 1) + 64 * c + lane;
            const unsigned selm = selw[w];
            const bool pred = (selm >> j) & 1u;
            const u64 m = __ballot(pred);
            const int n = __builtin_popcountll(m);
            unsigned base = 0u;
            if (n != 0) { if (lane == 0) base = __hip_atomic_fetch_add(qcnt, (unsigned)n, __ATOMIC_RELAXED, __HIP_MEMORY_SCOPE_WORKGROUP); base = (unsigned)__builtin_amdgcn_readfirstlane((int)base); }
            const int pos = (int)base + (int)__builtin_amdgcn_mbcnt_hi((unsigned)(m >> 32), __builtin_amdgcn_mbcnt_lo((unsigned)m, 0u));
            if (pred) qu16[pos] = (unsigned short)((unsigned)t | ((unsigned)__builtin_popcount(selm & ((1u << j) - 1u)) << 13)); }
    }
    asm volatile("s_waitcnt lgkmcnt(0)\n\ts_barrier" ::: "memory");
    const int cnt = (int)*(volatile unsigned*)qcnt;
    { const int tl = 32 * wid + r32; const int rowg = (int)rowbase + 256 * j + tl;
      moba_item<true>(rowg, tl, ((unsigned)rowg * 8u + (unsigned)h) * 4u + 3u, h, Q, PO, PML, lds, wid, lane); }
    for (int it = wid; it * 32 < cnt; it += 8) {
        const int e = it * 32 + r32; const unsigned ent = qu16[e < cnt ? e : cnt - 1];
        const int rowg = (int)rowbase + (int)(ent & 0x1FFFu);
        const unsigned dent = (e < cnt) ? (((unsigned)rowg * 8u + (unsigned)h) * 4u + (ent >> 13)) : ~0u;
        moba_item<false>(rowg, 0, dent, h, Q, PO, PML, lds, wid, lane);
    }
    asm volatile("s_waitcnt vmcnt(0) lgkmcnt(0)\n\ts_barrier" ::: "memory");
}
#undef SBAR
#undef PIN
#undef MFMA
#undef WAIT_BARW
#undef MX3
#undef MSK
}

template <int MODE>
__device__ __forceinline__ void phase_attn(const Params& P, char* lds) {
    unsigned char* ws = opaque_ptr(P.ws);
    const int G = o_grid(), c = o_blk(), vcu = (G % 8 == 0) ? (c % 8) * (G / 8) + c / 8 : c;
    for (int u = vcu; u < 512; u += G) {
        const int bh = u >> 5, j = u & 31, s = j >> 1, qb = (((j & 1) ^ (u >> 8)) & 1) ? 31 - s : s;
        const int b = bh >> 3, h = bh & 7;
        if (MODE == 0) att::attn_unit<0>(b, h, qb, (const f16*)(ws + WS_QB), (const f16*)(ws + WS_KB), (const f16*)(ws + WS_VB), (const f16*)(ws + WS_G), (f16*)(ws + WS_Y), 512, (const u64*)(ws + WS_BITS), nullptr, lds);
        else att::attn_unit<1>(b, h, qb, (const f16*)(ws + WS_QA), (const f16*)(ws + WS_KA), (const f16*)(ws + WS_VA), (const f16*)(ws + WS_G), (f16*)(ws + WS_Y), 0, nullptr, (const unsigned*)(ws + WS_SEL), lds);
    }
}

constexpr size_t WS_PO = WS_SC;
constexpr size_t WS_PML = WS_SC + 64 * MiB;
constexpr int CW_MOBAQ = 3584;
__device__ __forceinline__ void phase_moba_kv(const Params& P, int layer, char* lds) {
    unsigned char* ws = opaque_ptr(P.ws);
    unsigned* head = (unsigned*)(ws + WS_CTL) + CW_MOBAQ + 64 * layer;
    const int nu = 16 * 32;
    volatile unsigned* nxt = (volatile unsigned*)(lds + 131072 + 4096 + 32);
    for (;;) {
        const int tid = opaque_tid();
        if (tid == 0) *nxt = __hip_atomic_fetch_add(head, 1u, __ATOMIC_RELAXED, __HIP_MEMORY_SCOPE_AGENT);
        __syncthreads();
        int u = (int)*nxt;
        __syncthreads();
        if (u >= nu) break;
        att::moba_kv_unit(u & 15, u >> 4, (const f16*)(ws + WS_QA), (const f16*)(ws + WS_KA), (const f16*)(ws + WS_VA), (const unsigned*)(ws + WS_SEL), (f16*)(ws + WS_PO), (float*)(ws + WS_PML), lds);
    }
}
__device__ __forceinline__ void phase_moba_combine(const Params& P) {
    unsigned char* ws = opaque_ptr(P.ws);
    const int gtid = o_blk() * 512 + opaque_tid(), gthreads = o_grid() * 512;
    const unsigned* SEL = (const unsigned*)(ws + WS_SEL); const f16* PO = (const f16*)(ws + WS_PO); const float* PML = (const float*)(ws + WS_PML);
    const f16* G = (const f16*)(ws + WS_G); f16* Y = (f16*)(ws + WS_Y);
    for (int it = gtid; it < M * 64; it += gthreads) {
        const int ch = it & 7, rh = it >> 3, h = rh & 7, row = rh >> 3;
        const int np = __builtin_popcount(SEL[rh]);
        float mr[4], lw[4]; float mx = -INFINITY;
        const int pvb = __float_as_int(PML[(size_t)rh * 8 + ch]); const int lb4 = ((gtid & 63) & ~7) * 4;
#pragma unroll
        for (int sl = 0; sl < 4; ++sl) { const bool v = (sl == 3) || (sl < np);
            const float m_ = __int_as_float(__builtin_amdgcn_ds_bpermute(lb4 + 8 * sl, pvb)), l_ = __int_as_float(__builtin_amdgcn_ds_bpermute(lb4 + 8 * sl + 4, pvb));
            mr[sl] = v ? m_ : -INFINITY; lw[sl] = v ? l_ : 0.f; mx = fmaxf(mx, mr[sl]); }
        float wsum = 0.f; float acc[8];
#pragma unroll
        for (int k = 0; k < 8; ++k) acc[k] = 0.f;
#pragma unroll
        for (int sl = 0; sl < 4; ++sl) { const bool v = (sl == 3) || (sl < np);
            if (v) { const float w = __builtin_amdgcn_exp2f(mr[sl] - mx) * lw[sl]; wsum += w;
                const f16x8 ov = *(const f16x8*)(PO + ((size_t)rh * 4 + sl) * 64 + ch * 8);
#pragma unroll
                for (int k = 0; k < 8; ++k) acc[k] = __builtin_fmaf(w, (float)ov[k], acc[k]); } }
        const float rw = 1.0f / wsum;
        const size_t go = (size_t)row * 1536 + h * 64 + ch * 8;
        const f16x8 gv = *(const f16x8*)(G + go);
        u32x4 w; w.x = pk_f16(acc[0] * rw * (float)gv[0], acc[1] * rw * (float)gv[1]); w.y = pk_f16(acc[2] * rw * (float)gv[2], acc[3] * rw * (float)gv[3]);
        w.z = pk_f16(acc[4] * rw * (float)gv[4], acc[5] * rw * (float)gv[5]); w.w = pk_f16(acc[6] * rw * (float)gv[6], acc[7] * rw * (float)gv[7]);
        *(u32x4*)(Y + go) = w;
    }
}

__device__ __forceinline__ void phase_final(const Params& P) {
    unsigned char* ws = opaque_ptr(P.ws);
    const int gtid = o_blk() * 512 + opaque_tid(), lane = gtid & 63, gw = gtid >> 6, ngw = (o_grid() * 512) >> 6;
    const f16* xh = (const f16*)(ws + WS_XH); const float* ss = (const float*)(ws + WS_SS);
    for (int r = gw; r < M; r += ngw) {
        const float p = (lane < 16) ? ss[(size_t)r * 16 + lane] : 0.f;
        const float rs = __builtin_amdgcn_rsqf(wave_sum(p) * (1.0f / DM) + RMS_EPS);
        const f16x8* xr = (const f16x8*)(xh + (size_t)r * DM) + lane;
        f32x4* o = (f32x4*)(P.out + (size_t)r * DM) + 2 * lane;
#pragma unroll
        for (int j = 0; j < 2; ++j) { const f16x8 v = xr[64 * j]; const f32x4 g0 = ((const f32x4*)P.final_g)[128 * j + 2 * lane], g1 = ((const f32x4*)P.final_g)[128 * j + 2 * lane + 1];
            o[128 * j] = (f32x4){(float)v[0] * rs * g0[0], (float)v[1] * rs * g0[1], (float)v[2] * rs * g0[2], (float)v[3] * rs * g0[3]};
            o[128 * j + 1] = (f32x4){(float)v[4] * rs * g1[0], (float)v[5] * rs * g1[1], (float)v[6] * rs * g1[2], (float)v[7] * rs * g1[3]}; }
    }
}

#define XB_TMO      128
#define XB_XCNT(j)  (256  + 64 * (j))
#define XB_XSUB(j)  (1280 + 64 * (j))
#define XB_XGEN(j)  (2304 + 64 * (j))
#define XB_TOP      3328
#define XB_TOPGEN   3392
#define XCD_BAR_WORDS 3456
#define XB_SPIN_CAP (1u << 22)
__device__ __forceinline__ unsigned xb_ld(unsigned* p)              { return __hip_atomic_load(p, __ATOMIC_RELAXED, __HIP_MEMORY_SCOPE_AGENT); }
__device__ __forceinline__ unsigned xb_add(unsigned* p, unsigned v) { return __hip_atomic_fetch_add(p, v, __ATOMIC_RELAXED, __HIP_MEMORY_SCOPE_AGENT); }
__device__ __forceinline__ unsigned xb_xcc_id() { return (unsigned)__builtin_amdgcn_s_getreg((3 << 11) | 20) & 0xFu; }
#define XB_SPIN(cond, bar) do { unsigned _sp = 0; while (cond) { __builtin_amdgcn_s_sleep(1); \
    if ((++_sp & 255u) == 0u) { if (xb_ld(&(bar)[XB_TMO])) break; if (_sp > XB_SPIN_CAP) { atomicAdd(&(bar)[XB_TMO], 1u); break; } } } } while (0)
struct XcdBarrier { unsigned* bar; unsigned x; volatile LAS unsigned* st; };
__device__ __forceinline__ XcdBarrier xcd_barrier_post(unsigned* bar, volatile LAS unsigned* st) {
    XcdBarrier b; b.bar = bar; b.x = xb_xcc_id(); b.st = st;
    if (opaque_tid() == 0) (void)xb_add(&bar[XB_XCNT(b.x)], 1u);
    return b;
}
__device__ __forceinline__ void xcd_barrier_complete(unsigned* bar, unsigned x, unsigned& nloc, unsigned& nx) {
    const unsigned G = gridDim.x * gridDim.y * gridDim.z;
    unsigned sum, cnt, mine, sp = 0u;
    for (;;) {
        sum = 0u; cnt = 0u; mine = 0u;
#pragma unroll
        for (unsigned j = 0; j < 16; ++j) { const unsigned c = xb_ld(&bar[XB_XCNT(j)]); sum += c; cnt += (c > 0u) ? 1u : 0u; mine = (j == x) ? c : mine; }
        if (sum == G) break;
        __builtin_amdgcn_s_sleep(1);
        if ((++sp & 255u) == 0u) { if (xb_ld(&bar[XB_TMO])) break; if (sp > XB_SPIN_CAP) { atomicAdd(&bar[XB_TMO], 1u); break; } }
    }
    nloc = mine > 0u ? mine : 1u; nx = cnt > 0u ? cnt : 1u;
}
__device__ __forceinline__ void xcd_barrier(const XcdBarrier& b) {
    asm volatile("s_waitcnt vmcnt(0)" ::: "memory");
    __syncthreads();
    if (opaque_tid() == 0) {
        unsigned* bar = (unsigned*)opaque_ptr((unsigned char*)b.bar);
        __builtin_amdgcn_s_waitcnt(0);
        unsigned bx = b.x; asm volatile("" : "+s"(bx));
        unsigned nloc = b.st[0], nx = b.st[1];
        if (nloc == 0u) { xcd_barrier_complete(bar, bx, nloc, nx); b.st[0] = nloc; b.st[1] = nx; }
        const unsigned old = xb_add(&bar[XB_XSUB(bx)], 1u);
        const unsigned gen = old / nloc;
        if (old + 1u == (gen + 1u) * nloc) {
            __builtin_amdgcn_fence(__ATOMIC_RELEASE, "agent");
            asm volatile("s_waitcnt vmcnt(0)" ::: "memory");
            const unsigned og = xb_add(&bar[XB_TOP], 1u);
            const unsigned tg = og / nx;
            if (og + 1u == (tg + 1u) * nx) xb_add(&bar[XB_TOPGEN], 1u);
            else XB_SPIN(xb_ld(&bar[XB_TOPGEN]) == tg, bar);
            __builtin_amdgcn_fence(__ATOMIC_ACQUIRE, "agent");
            xb_add(&bar[XB_XGEN(bx)], 1u);
            asm volatile("s_waitcnt vmcnt(0)" ::: "memory");
        } else {
            XB_SPIN(xb_ld(&bar[XB_XGEN(bx)]) == gen, bar);
            __builtin_amdgcn_fence(__ATOMIC_ACQUIRE, "agent");
            asm volatile("s_waitcnt vmcnt(0)" ::: "memory");
        }
    }
    __syncthreads();
}


#ifndef REP_PRO
#define REP_PRO 1
#endif
#ifndef REP_INP
#define REP_INP 1
#endif
#ifndef REP_MEM
#define REP_MEM 1
#endif
#ifndef REP_IDX
#define REP_IDX 1
#endif
#ifndef REP_SEL
#define REP_SEL 1
#endif
#ifndef REP_GATE
#define REP_GATE 1
#endif
#ifndef REP_A0
#define REP_A0 1
#endif
#ifndef REP_A1
#define REP_A1 1
#endif
#ifndef REP_MRG
#define REP_MRG 1
#endif
#ifndef REP_OUT
#define REP_OUT 1
#endif
#ifndef REP_FIN
#define REP_FIN 1
#endif
#ifndef REP_BAR
#define REP_BAR 1
#endif
constexpr int LDS_BYTES = 147456;
__global__ void __launch_bounds__(512, 2) trunk_fwd(Params P) {
    extern __shared__ __attribute__((aligned(16))) unsigned char lds_raw[];
    LAS unsigned char* lds = (LAS unsigned char*)lds_raw;
    unsigned* barw = (unsigned*)(P.ws + WS_CTL);
    volatile LAS unsigned* bst = (volatile LAS unsigned*)(lds + 131072 + 4096);
    {
        const unsigned t0 = threadIdx.x;
        const unsigned hw = (unsigned)__builtin_amdgcn_s_getreg((5 << 11) | 4) & 63u;
        if ((t0 & 63u) == 0u) ((volatile LAS unsigned*)(lds + WTAB_OFF))[hw] = t0 >> 6;
        if (t0 < 2) bst[t0] = 0u;
        if (blockIdx.x == 0) for (int i = t0; i < 4096; i += 512) barw[i] = 0u;
        __syncthreads();
    }
    for (int rep = 0; rep < REP_PRO; ++rep) phase_prologue(P, lds);
    cg::this_grid().sync();
    const XcdBarrier bar = xcd_barrier_post(barw, bst);
#define GRID_BAR() do { for (int rep_ = 0; rep_ < REP_BAR; ++rep_) xcd_barrier(bar); } while (0)
    for (int l = 0; l < DEPTH; ++l) {
        for (int rep = 0; rep < REP_INP; ++rep) { unsigned char* wso = opaque_ptr(P.ws); SchedInproj S{wso, l, o_grid(), o_blk()}; Epi<0> E{wso, nullptr, nullptr, l, lds + 131072 + 8192}; pg8::gemm_phase<2048, 2048, 16>(lds, S, E); }
        GRID_BAR();
        for (int rep = 0; rep < REP_MEM; ++rep) phase_memattn(P, l, lds);
        for (int ch = 0; ch < NCHUNK; ++ch) {
            for (int rep = 0; rep < REP_IDX; ++rep) phase_index(P, ch, lds);
            GRID_BAR();
            for (int rep = 0; rep < REP_SEL; ++rep) phase_select(P, ch, lds);
            if (ch == 0) for (int rep = 0; rep < REP_GATE; ++rep) phase_gate(P, lds);
            GRID_BAR();
        }
        for (int rep = 0; rep < REP_A0; ++rep) phase_attn<0>(P, (char*)lds_raw);
        for (int rep = 0; rep < REP_A1; ++rep) phase_moba_kv(P, l, (char*)lds_raw);
        GRID_BAR();
        phase_moba_combine(P);
        GRID_BAR();
        for (int rep = 0; rep < REP_MRG; ++rep) {
            { unsigned char* wso = opaque_ptr(P.ws); SchedUp S{wso, l, o_grid(), o_blk()}; Epi<1> E{wso, nullptr, nullptr, l, lds + 131072 + 8192}; pg8::gemm_phase<3072, 1024, 8>(lds, S, E); }
            { unsigned char* wso = opaque_ptr(P.ws); SchedMix S{wso, l, o_grid(), o_blk()}; Epi<2> E{wso, nullptr, nullptr, l, lds + 131072 + 8192}; pg8::gemm_phase<2048, 2048, 16>(lds, S, E); }
        }
        GRID_BAR();
        for (int rep = 0; rep < (l == 0 ? REP_OUT : 1); ++rep) { unsigned char* wso = opaque_ptr(P.ws); SchedOut S{wso, l, o_grid(), o_blk()}; Epi<3> E{wso, l == 0 ? P.x : P.out, P.out, l, lds + 131072 + 8192}; pg8::gemm_phase<2048, 6144, 16>(lds, S, E); }
        GRID_BAR();
    }
    phase_final(P);
}

extern "C" void kernel_launch(void* const* d_in, const int* in_sizes, int n_in, void* d_out, int out_size, void* d_ws, size_t ws_size, hipStream_t stream) {
    static int grid = 0;
    if (grid == 0) {
        if (n_in != 9 || out_size != M * DM || ws_size < WS_END) { fprintf(stderr, "kernel_launch: unexpected sizes (n_in %d out %d ws %zu need %zu)\n", n_in, out_size, ws_size, (size_t)WS_END); grid = -1; return; }
        int dev = 0, cus = 0, per_cu = 0;
        hipGetDevice(&dev); hipDeviceGetAttribute(&cus, hipDeviceAttributeMultiprocessorCount, dev);
        if (hipFuncSetAttribute((const void*)trunk_fwd, hipFuncAttributeMaxDynamicSharedMemorySize, LDS_BYTES) != hipSuccess) { fprintf(stderr, "kernel_launch: hipFuncSetAttribute failed\n"); grid = -1; return; }
        hipOccupancyMaxActiveBlocksPerMultiprocessor(&per_cu, (const void*)trunk_fwd, 512, LDS_BYTES);
        (void)hipGetLastError();
        if (per_cu < 1) { fprintf(stderr, "kernel_launch: occupancy query says %d blocks per CU\n", per_cu); grid = -1; return; }
        grid = cus;
    }
    if (grid < 0) return;
    Params p{};
    p.x = (const float*)d_in[0]; p.mem = (const float*)d_in[1]; p.norm_g = (const float*)d_in[2]; p.w_in = (const float*)d_in[3]; p.mem_norm_g = (const float*)d_in[4];
    p.w_mem_kv = (const float*)d_in[5]; p.w_branch = (const float*)d_in[6]; p.w_out = (const float*)d_in[7]; p.final_g = (const float*)d_in[8];
    p.out = (float*)d_out; p.ws = (unsigned char*)d_ws;
    void* args[] = {&p};
    hipError_t e = hipLaunchCooperativeKernel((const void*)trunk_fwd, dim3(grid), dim3(512), args, LDS_BYTES, stream);
    if (e != hipSuccess) fprintf(stderr, "kernel_launch: cooperative launch failed: %s (grid %d)\n", hipGetErrorString(e), grid);
}
```
